# Optimizing an MI355X kernel written in HIP

```python
import jax, jax.numpy as jnp
from jax import lax
import numpy as np

D_MODEL = 1024
BATCH = 32
SEQ = 2048
DEPTH = 4

ROPE_BASE = 10000.0
NORM_EPS = 1e-6
MLA_HEADS = D_MODEL // 128
MLA_QK_NOPE = 128
MLA_QK_ROPE = 64
MLA_V_DIM = 128
MLA_Q_LORA = 3 * D_MODEL // 8
MLA_KV_LORA = D_MODEL // 8
ATTN_Q_BLOCK = 128
POOL_WINDOWS = (2, 4, 8, 16)
POOL_GROUPS = len(POOL_WINDOWS)
POOL_GROUP_DIM = D_MODEL // POOL_GROUPS
MIX_A = MLA_HEADS * MLA_V_DIM
MIX_B = POOL_GROUPS * POOL_GROUP_DIM
EVEN_MIX = MIX_A + MIX_B
EVEN_SPLITS = (MLA_Q_LORA, MLA_Q_LORA + MLA_KV_LORA, MLA_Q_LORA + MLA_KV_LORA + MLA_QK_ROPE,
               MLA_Q_LORA + MLA_KV_LORA + MLA_QK_ROPE + MIX_B)
EVEN_IN = EVEN_SPLITS[-1] + EVEN_MIX
RET_HEADS = D_MODEL // 256
RET_DK = 256
RET_DV = 512
RET_CHUNK = 128
RET_QK = RET_HEADS * RET_DK
RET_V = RET_HEADS * RET_DV
ODD_IN = 2 * RET_QK + 2 * RET_V
N_EVEN = (DEPTH + 1) // 2
N_ODD = DEPTH // 2

kernel_name = 'hybrid_mla_pool_retention_encoder'


def rms_norm(x, g):
    xf = x.astype(jnp.float32)
    y = xf * lax.rsqrt(jnp.mean(xf * xf, axis=-1, keepdims=True) + NORM_EPS)
    return (y * g.astype(jnp.float32)).astype(x.dtype)


def rope_tables(positions, dim):
    inv = 1.0 / (ROPE_BASE ** (jnp.arange(0, dim, 2, dtype=jnp.float32) / dim))
    ang = positions.astype(jnp.float32)[..., None] * inv
    return jnp.cos(ang)[:, :, None, :], jnp.sin(ang)[:, :, None, :]


def apply_rope(x, cos, sin):
    half = x.shape[-1] // 2
    xf = x.astype(jnp.float32)
    x1, x2 = xf[..., :half], xf[..., half:]
    return jnp.concatenate([x1 * cos - x2 * sin, x2 * cos + x1 * sin], axis=-1).astype(x.dtype)


def mla(cq, ckv, kr, cos, sin, q_norm_g, w_uq, kv_norm_g, w_ukv):
    B_, T, _ = cq.shape
    dqk = MLA_QK_NOPE + MLA_QK_ROPE
    q = (rms_norm(cq, q_norm_g) @ w_uq).reshape(B_, T, MLA_HEADS, dqk)
    q = jnp.concatenate([q[..., :MLA_QK_NOPE], apply_rope(q[..., MLA_QK_NOPE:], cos, sin)], axis=-1)
    kv = (rms_norm(ckv, kv_norm_g) @ w_ukv).reshape(B_, T, MLA_HEADS, MLA_QK_NOPE + MLA_V_DIM)
    k_rope = apply_rope(kr[:, :, None, :], cos, sin)
    k = jnp.concatenate([kv[..., :MLA_QK_NOPE],
                         jnp.broadcast_to(k_rope, (B_, T, MLA_HEADS, MLA_QK_ROPE))], axis=-1)
    v = kv[..., MLA_QK_NOPE:]
    nb = T // ATTN_Q_BLOCK
    qb = q.reshape(B_, nb, ATTN_Q_BLOCK, MLA_HEADS, dqk).transpose(1, 0, 2, 3, 4)
    scale = dqk ** -0.5

    def attend(q_blk):
        s = jnp.einsum('bqhd,bkhd->bhqk', q_blk, k, preferred_element_type=jnp.float32) * scale
        p = jax.nn.softmax(s, axis=-1).astype(v.dtype)
        return jnp.einsum('bhqk,bkhd->bqhd', p, v)

    o = lax.map(attend, qb)
    return o.transpose(1, 0, 2, 3, 4).reshape(B_, T, MIX_A)


def multiscale_pool(u, pool_w, pool_scale):
    B_, T, _ = u.shape
    uf = u.reshape(B_, T, POOL_GROUPS, POOL_GROUP_DIM).astype(jnp.float32)
    cs = jnp.concatenate([jnp.zeros_like(uf[:, :1]), jnp.cumsum(uf, axis=1)], axis=1)
    t = jnp.arange(T)
    outs = []
    for g, w in enumerate(POOL_WINDOWS):
        left = w // 2
        right = w - 1 - left
        lo = jnp.clip(t - left, 0, T - 1)
        hi = jnp.clip(t + right, 0, T - 1)
        csg = cs[:, :, g]
        s = jnp.take(csg, hi + 1, axis=1) - jnp.take(csg, lo, axis=1)
        cnt = (hi - lo + 1).astype(jnp.float32)
        outs.append(s / cnt[None, :, None] - uf[:, :, g])
    d = jnp.stack(outs, axis=2).astype(u.dtype)
    y = jnp.einsum('btgc,gcd->btgd', d, pool_w) * pool_scale.reshape(POOL_GROUPS, POOL_GROUP_DIM)
    return y.reshape(B_, T, MIX_B)


def hybrid_attn_pool_layer(x, cos_a, sin_a, norm_g, w_in, q_norm_g, w_uq, kv_norm_g, w_ukv,
                           pool_w, pool_scale, w_out):
    h = rms_norm(x, norm_g)
    proj = h @ w_in
    cq, ckv, kr, u, gate = jnp.split(proj, list(EVEN_SPLITS), axis=-1)
    a = mla(cq, ckv, kr, cos_a, sin_a, q_norm_g, w_uq, kv_norm_g, w_ukv)
    b = multiscale_pool(u, pool_w, pool_scale)
    y = jnp.concatenate([a, b], axis=-1) * jax.nn.silu(gate)
    return y @ w_out


def retention_chunkwise(q, k, v, log_g, include_diag):
    B_, T, H, dk = q.shape
    dv = v.shape[-1]
    C = RET_CHUNK
    N = T // C
    to_chunks = lambda a: a.reshape(B_, N, C, H, a.shape[-1]).transpose(1, 0, 3, 2, 4)
    qc, kc, vc = to_chunks(q), to_chunks(k), to_chunks(v)
    idx = jnp.arange(C).astype(jnp.float32)
    diff = idx[:, None] - idx[None, :]
    mask = (diff >= 0) if include_diag else (diff > 0)
    dmat = jnp.where(mask[None], jnp.exp(jnp.where(mask, diff, 0.0)[None] * log_g[:, None, None]), 0.0)
    xi = jnp.exp((idx + 1.0)[None, :] * log_g[:, None])[None, :, :, None]
    zeta = jnp.exp((C - 1.0 - idx)[None, :] * log_g[:, None])[None, :, :, None]
    chunk_decay = jnp.exp(C * log_g)[None, :, None, None]

    def step(state, inp):
        q_i, k_i, v_i = inp
        scores = jnp.einsum('bhid,bhjd->bhij', q_i, k_i) * dmat
        o_in = jnp.einsum('bhij,bhjv->bhiv', scores, v_i)
        o_cross = jnp.einsum('bhid,bhdv->bhiv', q_i, state) * xi
        state = state * chunk_decay + jnp.einsum('bhjd,bhjv->bhdv', k_i * zeta, v_i)
        return state, o_in + o_cross

    s0 = jnp.zeros((B_, H, dk, dv), jnp.float32)
    _, o = lax.scan(step, s0, (qc, kc, vc))
    return o.transpose(1, 0, 3, 2, 4).reshape(B_, T, H, dv)


def retention_layer(x, cos_r, sin_r, norm_g, w_in, decay_fwd, decay_bwd, gn_g, w_out):
    B_, T, _ = x.shape
    h = rms_norm(x, norm_g)
    proj = h @ w_in
    q, k, v, gate = jnp.split(proj, [RET_QK, 2 * RET_QK, 2 * RET_QK + RET_V], axis=-1)
    q = apply_rope(q.reshape(B_, T, RET_HEADS, RET_DK), cos_r, sin_r).astype(jnp.float32)
    k = apply_rope(k.reshape(B_, T, RET_HEADS, RET_DK), cos_r, sin_r).astype(jnp.float32) * (RET_DK ** -0.5)
    v = v.reshape(B_, T, RET_HEADS, RET_DV).astype(jnp.float32)
    lf = jax.nn.log_sigmoid(decay_fwd.astype(jnp.float32))
    lb = jax.nn.log_sigmoid(decay_bwd.astype(jnp.float32))
    o_f = retention_chunkwise(q, k, v, lf, True)
    o_b = jnp.flip(retention_chunkwise(jnp.flip(q, 1), jnp.flip(k, 1), jnp.flip(v, 1), lb, False), 1)
    o = o_f + o_b
    mu = jnp.mean(o, axis=-1, keepdims=True)
    var = jnp.mean(jnp.square(o - mu), axis=-1, keepdims=True)
    o = ((o - mu) * lax.rsqrt(var + NORM_EPS)).reshape(B_, T, RET_V) * gn_g.astype(jnp.float32)
    y = o.astype(x.dtype) * jax.nn.silu(gate)
    return y @ w_out


def setup_inputs(seed: int = 0) -> dict:
    key = jax.random.key(seed)
    ks = jax.random.split(key, 24)
    f32 = jnp.float32
    nrm = lambda k, shape, scale: jax.random.normal(k, shape, f32) * scale
    gain = lambda k, shape: 1.0 + 0.05 * jax.random.normal(k, shape, f32)
    x = jax.random.normal(ks[0], (BATCH, SEQ, D_MODEL), f32)
    positions = (jnp.arange(SEQ, dtype=jnp.int32)[None, :]
                 + jax.random.randint(ks[1], (BATCH, 1), 0, 4096, dtype=jnp.int32))
    base_decay = jnp.log(2.0 ** (5.0 + jnp.arange(RET_HEADS, dtype=f32)) - 1.0)
    return {
        'x': x,
        'positions': positions,
        'a_norm_g': gain(ks[2], (N_EVEN, D_MODEL)),
        'a_w_in': nrm(ks[3], (N_EVEN, D_MODEL, EVEN_IN), D_MODEL ** -0.5),
        'a_q_norm_g': gain(ks[4], (N_EVEN, MLA_Q_LORA)),
        'a_w_uq': nrm(ks[5], (N_EVEN, MLA_Q_LORA, MLA_HEADS * (MLA_QK_NOPE + MLA_QK_ROPE)), MLA_Q_LORA ** -0.5),
        'a_kv_norm_g': gain(ks[6], (N_EVEN, MLA_KV_LORA)),
        'a_w_ukv': nrm(ks[7], (N_EVEN, MLA_KV_LORA, MLA_HEADS * (MLA_QK_NOPE + MLA_V_DIM)), MLA_KV_LORA ** -0.5),
        'a_pool_w': nrm(ks[8], (N_EVEN, POOL_GROUPS, POOL_GROUP_DIM, POOL_GROUP_DIM), POOL_GROUP_DIM ** -0.5),
        'a_pool_scale': 1.0 + 0.1 * jax.random.normal(ks[9], (N_EVEN, MIX_B), f32),
        'a_w_out': nrm(ks[10], (N_EVEN, EVEN_MIX, D_MODEL), EVEN_MIX ** -0.5),
        'r_norm_g': gain(ks[11], (N_ODD, D_MODEL)),
        'r_w_in': nrm(ks[12], (N_ODD, D_MODEL, ODD_IN), D_MODEL ** -0.5),
        'r_decay_fwd': base_decay[None, :] + 0.1 * jax.random.normal(ks[13], (N_ODD, RET_HEADS), f32),
        'r_decay_bwd': base_decay[None, :] + 0.1 * jax.random.normal(ks[14], (N_ODD, RET_HEADS), f32),
        'r_gn_g': gain(ks[15], (N_ODD, RET_V)),
        'r_w_out': nrm(ks[16], (N_ODD, RET_V, D_MODEL), RET_V ** -0.5),
        'final_norm_g': gain(ks[17], (D_MODEL,)),
    }


def reference(x, positions, a_norm_g, a_w_in, a_q_norm_g, a_w_uq, a_kv_norm_g, a_w_ukv,
              a_pool_w, a_pool_scale, a_w_out, r_norm_g, r_w_in, r_decay_fwd, r_decay_bwd,
              r_gn_g, r_w_out, final_norm_g):
    cos_a, sin_a = rope_tables(positions, MLA_QK_ROPE)
    cos_r, sin_r = rope_tables(positions, RET_DK)
    for layer in range(DEPTH):
        i = layer // 2
        if layer % 2 == 0:
            x = x + hybrid_attn_pool_layer(x, cos_a, sin_a, a_norm_g[i], a_w_in[i], a_q_norm_g[i],
                                           a_w_uq[i], a_kv_norm_g[i], a_w_ukv[i], a_pool_w[i],
                                           a_pool_scale[i], a_w_out[i])
        else:
            x = x + retention_layer(x, cos_r, sin_r, r_norm_g[i], r_w_in[i], r_decay_fwd[i],
                                    r_decay_bwd[i], r_gn_g[i], r_w_out[i])
    return rms_norm(x, final_norm_g)
```

```cpp
#include <hip/hip_runtime.h>
#include <hip/hip_cooperative_groups.h>
#include <hip/hip_fp16.h>
#include <cstdio>
namespace cg = cooperative_groups;
#ifndef DBG_MASK
#define DBG_MASK 15
#endif

typedef unsigned short u16;
using bf16x8 = __attribute__((ext_vector_type(8))) short;
using s16x4  = __attribute__((ext_vector_type(4))) short;
using f32x16 = __attribute__((ext_vector_type(16))) float;
using u32x4 = __attribute__((ext_vector_type(4))) unsigned;
using u32x2 = __attribute__((ext_vector_type(2))) unsigned;
#define DI __device__ __forceinline__
DI int tid_l() { int t = threadIdx.x; asm volatile("" : "+v"(t)); return t; }
#define MFMA32(a, b, c) __builtin_amdgcn_mfma_f32_32x32x16_bf16((a), (b), (c), 0, 0, 0)

constexpr int M_TOT = 65536, MH = 32768, TSEQ = 2048, DM = 1024;
constexpr int EIN = 3648, EIN_PAD = 3712, GATE0 = 1600, U0 = 576;
constexpr int NTHR = 256;
constexpr float EPS = 1e-6f;

constexpr size_t MiB = 1024ull * 1024ull;
constexpr size_t SZ_A_WIN = (size_t)EIN_PAD * 1024 * 2, SZ_A_WUQ = 1536ull * 384 * 2, SZ_A_WUKV = 2048ull * 128 * 2, SZ_A_POOL = 4ull * 256 * 256 * 2,
                 SZ_A_WOUT = 1024ull * 2048 * 2, SZ_R_WIN = 6144ull * 1024 * 2, SZ_R_WOUT = 1024ull * 2048 * 2;
constexpr size_t OFF_A_WIN = 0, OFF_A_WUQ = OFF_A_WIN + 2 * SZ_A_WIN, OFF_A_WUKV = OFF_A_WUQ + 2 * SZ_A_WUQ, OFF_A_POOL = OFF_A_WUKV + 2 * SZ_A_WUKV,
                 OFF_A_WOUT = OFF_A_POOL + 2 * SZ_A_POOL, OFF_R_WIN = OFF_A_WOUT + 2 * SZ_A_WOUT, OFF_R_WOUT = OFF_R_WIN + 2 * SZ_R_WIN,
                 OFF_TAB = OFF_R_WOUT + 2 * SZ_R_WOUT, OFF_ACT = ((OFF_TAB + (size_t)M_TOT * 128 * 4 + 255) / 256) * 256;
constexpr size_t E_H = OFF_ACT, E_PROJ = E_H + 64 * MiB, E_CQN = E_PROJ + (size_t)MH * EIN * 2, E_CKVN = E_CQN + 24 * MiB, E_KR = E_CKVN + 8 * MiB,
                 E_DP = E_KR + 4 * MiB, E_Q = E_DP + 64 * MiB, E_KN = E_Q + 96 * MiB, E_VT = E_KN + 64 * MiB, E_Y = E_VT + 64 * MiB, E_END = E_Y + 128 * MiB;
constexpr size_t O_H = OFF_ACT, O_Q = O_H + 64 * MiB, O_K = O_Q + 64 * MiB, O_KFT = O_K + 64 * MiB, O_KBT = O_KFT + 64 * MiB, O_VT = O_KBT + 64 * MiB,
                 O_GATE = O_VT + 128 * MiB, O_O = O_GATE + 128 * MiB, O_P = O_O + 128 * MiB, O_SF = O_P + 32 * MiB, O_SB = O_SF + 32 * MiB, O_END = O_SB + 16 * MiB;
constexpr size_t WS_NEED = E_END > O_END ? E_END : O_END;

constexpr int GT_TILE = 128 * 144;
constexpr int LDS_BYTES = 4 * GT_TILE;

struct Params {
  const float* x; const int* pos;
  const float* a_norm_g; const float* a_w_in; const float* a_q_norm_g; const float* a_w_uq; const float* a_kv_norm_g; const float* a_w_ukv;
  const float* a_pool_w; const float* a_pool_scale; const float* a_w_out;
  const float* r_norm_g; const float* r_w_in; const float* r_decay_fwd; const float* r_decay_bwd; const float* r_gn_g; const float* r_w_out;
  const float* final_norm_g;
  float* out; char* ws;
};

typedef __bf16 bf16x2_t __attribute__((ext_vector_type(2)));
typedef float f32x2_t __attribute__((ext_vector_type(2)));
DI unsigned cvtpk(float lo, float hi) { f32x2_t f = {lo, hi}; bf16x2_t b = __builtin_convertvector(f, bf16x2_t); return __builtin_bit_cast(unsigned, b); }
DI u16 f2bf(float x) { return (u16)(cvtpk(x, 0.f) & 0xffffu); }
DI float bflo(unsigned w) { return __uint_as_float(w << 16); }
DI float bfhi(unsigned w) { return __uint_as_float(w & 0xffff0000u); }
DI float bf2f(u16 v) { return __uint_as_float(((unsigned)v) << 16); }
DI float wave_sum(float v) { for (int o = 32; o > 0; o >>= 1) v += __shfl_xor(v, o, 64); return v; }
DI float silu(float g) { return g / (1.f + __expf(-g)); }
DI void store4bf(u16* p, float a, float b, float c, float d) { uint2 w; w.x = cvtpk(a, b); w.y = cvtpk(c, d); *reinterpret_cast<uint2*>(p) = w; }
DI void load4bf(const u16* p, float& a, float& b, float& c, float& d) { uint2 w = *reinterpret_cast<const uint2*>(p); a = bflo(w.x); b = bfhi(w.x); c = bflo(w.y); d = bfhi(w.y); }
DI void rope_cs(const unsigned* tab, long mg, int idx, float& c, float& s) {
  unsigned u = tab[mg * 128 + idx]; __half2 h = *reinterpret_cast<__half2*>(&u); c = __low2float(h); s = __high2float(h);
}
DI float log_sigmoid(float x) { return -log1pf(expf(-x)); }

template <class Epi>
DI void gemm_tile(const u16* __restrict__ A, long lda, const u16* __restrict__ Bt, long ldb, int K, char* lds, Epi epi) {
  const int tid = tid_l(), lane = tid & 63, wave = tid >> 6, wm = wave >> 1, wn = wave & 1, l31 = lane & 31, hi = lane >> 5;
  const int lr = tid >> 3, lc = tid & 7;
  const u16* ag = A + (long)lr * lda + lc * 8;
  const u16* bg = Bt + (long)lr * ldb + lc * 8;
  u32x4 ra[4], rb[4];
#pragma unroll
  for (int i = 0; i < 4; ++i) { ra[i] = *reinterpret_cast<const u32x4*>(ag + (long)(32 * i) * lda); rb[i] = *reinterpret_cast<const u32x4*>(bg + (long)(32 * i) * ldb); }
  f32x16 acc[2][2];
#pragma unroll
  for (int a = 0; a < 2; ++a)
#pragma unroll
    for (int b = 0; b < 2; ++b)
#pragma unroll
      for (int r = 0; r < 16; ++r) acc[a][b][r] = 0.f;
  char* wbase = lds + lr * 144 + lc * 16;
#pragma unroll
  for (int i = 0; i < 4; ++i) { *reinterpret_cast<u32x4*>(wbase + i * 32 * 144) = ra[i]; *reinterpret_cast<u32x4*>(wbase + GT_TILE + i * 32 * 144) = rb[i]; }
  __syncthreads();
  const int nk = K >> 6;
  for (int kt = 0; kt < nk; ++kt) {
    const int cur = kt & 1;
    if (kt + 1 < nk) {
#pragma unroll
      for (int i = 0; i < 4; ++i) {
        ra[i] = *reinterpret_cast<const u32x4*>(ag + (long)(32 * i) * lda + (kt + 1) * 64);
        rb[i] = *reinterpret_cast<const u32x4*>(bg + (long)(32 * i) * ldb + (kt + 1) * 64);
      }
    }
    const char* as = lds + cur * 2 * GT_TILE + (wm * 64 + l31) * 144 + hi * 16;
    const char* bs = lds + cur * 2 * GT_TILE + GT_TILE + (wn * 64 + l31) * 144 + hi * 16;
#pragma unroll
    for (int kk = 0; kk < 4; ++kk) {
      bf16x8 a0 = *reinterpret_cast<const bf16x8*>(as + kk * 32);
      bf16x8 a1 = *reinterpret_cast<const bf16x8*>(as + 32 * 144 + kk * 32);
      bf16x8 b0 = *reinterpret_cast<const bf16x8*>(bs + kk * 32);
      bf16x8 b1 = *reinterpret_cast<const bf16x8*>(bs + 32 * 144 + kk * 32);
      acc[0][0] = MFMA32(b0, a0, acc[0][0]);
      acc[0][1] = MFMA32(b0, a1, acc[0][1]);
      acc[1][0] = MFMA32(b1, a0, acc[1][0]);
      acc[1][1] = MFMA32(b1, a1, acc[1][1]);
    }
    if (kt + 1 < nk) {
      char* wb = wbase + (cur ^ 1) * 2 * GT_TILE;
#pragma unroll
      for (int i = 0; i < 4; ++i) { *reinterpret_cast<u32x4*>(wb + i * 32 * 144) = ra[i]; *reinterpret_cast<u32x4*>(wb + GT_TILE + i * 32 * 144) = rb[i]; }
    }
    __syncthreads();
  }
#pragma unroll
  for (int ns = 0; ns < 2; ++ns)
#pragma unroll
    for (int ms = 0; ms < 2; ++ms)
#pragma unroll
      for (int g = 0; g < 4; ++g) {
        const int m = wm * 64 + ms * 32 + l31, n = wn * 64 + ns * 32 + 8 * g + 4 * hi;
        epi(m, n, acc[ns][ms][4 * g], acc[ns][ms][4 * g + 1], acc[ns][ms][4 * g + 2], acc[ns][ms][4 * g + 3]);
        __builtin_amdgcn_sched_barrier(0);
      }
}

DI int map_row(int mode, int n) {
  if (mode == 1) { if (n >= 512 && n < 576) { int j = n - 512; return 512 + (j < 32 ? 2 * j : 2 * (j - 32) + 1); } return n; }
  if (mode == 2) { int w = n % 192; if (w >= 128) { int j = w - 128; return n - w + 128 + (j < 32 ? 2 * j : 2 * (j - 32) + 1); } return n; }
  if (mode == 3) { if (n < 2048) { int w = n & 255; return n - w + (w < 128 ? 2 * w : 2 * (w - 128) + 1); } return n; }
  return n;
}
DI void transpose_job(const float* __restrict__ src, int K, int N, u16* __restrict__ dst, int mode, float* lds) {
  const int ntn = N >> 6, ntiles = (K >> 6) * ntn, tid = tid_l(), c = tid & 63, r0 = tid >> 6;
  for (int tile = blockIdx.x; tile < ntiles; tile += gridDim.x) {
    const int kt = tile / ntn, nt = tile - kt * ntn;
#pragma unroll 4
    for (int i = 0; i < 16; ++i) { int r = r0 + 4 * i; lds[r * 65 + c] = src[(long)(kt * 64 + r) * N + nt * 64 + c]; }
    __syncthreads();
#pragma unroll 4
    for (int i = 0; i < 16; ++i) { int rr = r0 + 4 * i; int dn = map_row(mode, nt * 64 + rr); dst[(long)dn * K + kt * 64 + c] = f2bf(lds[c * 65 + rr]); }
    __syncthreads();
  }
}

DI void phase_prep(const Params& p, char* lds) {
  float* fl = reinterpret_cast<float*>(lds);
  char* ws = p.ws;
  for (int i = 0; i < 2; ++i) {
    transpose_job(p.a_w_in + (size_t)i * 1024 * EIN, 1024, EIN, (u16*)(ws + OFF_A_WIN + i * SZ_A_WIN), 1, fl);
    transpose_job(p.a_w_uq + (size_t)i * 384 * 1536, 384, 1536, (u16*)(ws + OFF_A_WUQ + i * SZ_A_WUQ), 2, fl);
    transpose_job(p.a_w_ukv + (size_t)i * 128 * 2048, 128, 2048, (u16*)(ws + OFF_A_WUKV + i * SZ_A_WUKV), 0, fl);
    for (int g = 0; g < 4; ++g)
      transpose_job(p.a_pool_w + ((size_t)i * 4 + g) * 65536, 256, 256, (u16*)(ws + OFF_A_POOL + i * SZ_A_POOL) + g * 65536, 0, fl);
    transpose_job(p.a_w_out + (size_t)i * 2048 * 1024, 2048, 1024, (u16*)(ws + OFF_A_WOUT + i * SZ_A_WOUT), 0, fl);
    transpose_job(p.r_w_in + (size_t)i * 1024 * 6144, 1024, 6144, (u16*)(ws + OFF_R_WIN + i * SZ_R_WIN), 3, fl);
    transpose_job(p.r_w_out + (size_t)i * 2048 * 1024, 2048, 1024, (u16*)(ws + OFF_R_WOUT + i * SZ_R_WOUT), 0, fl);
    u16* pad = (u16*)(ws + OFF_A_WIN + i * SZ_A_WIN) + (size_t)EIN * 1024;
    for (int e = blockIdx.x * NTHR + tid_l(); e < (EIN_PAD - EIN) * 1024; e += gridDim.x * NTHR) pad[e] = 0;
  }
  unsigned* tab = (unsigned*)(ws + OFF_TAB);
  for (int e = blockIdx.x * NTHR + tid_l(); e < M_TOT * 128; e += gridDim.x * NTHR) {
    const int mg = e >> 7, i = e & 127;
    const float inv = exp2f(-(float)i * (13.287712379549449f / 128.f));
    const double ang = (double)p.pos[mg] * (double)inv;
    const double kk = rint(ang * 0.15915494309189535);
    const float r = (float)(ang - kk * 6.283185307179586);
    __half2 h = __floats2half2_rn(__cosf(r), __sinf(r));
    tab[e] = *reinterpret_cast<unsigned*>(&h);
  }
}

DI void phase_rownorm(const float* __restrict__ xin, const float* __restrict__ g, u16* __restrict__ h, int hf) {
  const int lane = tid_l() & 63, gw = blockIdx.x * 4 + (tid_l() >> 6), nw = gridDim.x * 4;
  for (int m = gw; m < MH; m += nw) {
    const float* xr = xin + ((size_t)hf * MH + m) * DM;
    float4 v[4]; float ss = 0.f;
#pragma unroll
    for (int i = 0; i < 4; ++i) { v[i] = *reinterpret_cast<const float4*>(xr + (i * 64 + lane) * 4); ss += v[i].x * v[i].x + v[i].y * v[i].y + v[i].z * v[i].z + v[i].w * v[i].w; }
    ss = wave_sum(ss);
    const float rs = rsqrtf(ss * (1.f / DM) + EPS);
#pragma unroll
    for (int i = 0; i < 4; ++i) {
      const int c = (i * 64 + lane) * 4; const float4 gg = *reinterpret_cast<const float4*>(g + c);
      store4bf(h + (size_t)m * DM + c, v[i].x * rs * gg.x, v[i].y * rs * gg.y, v[i].z * rs * gg.z, v[i].w * rs * gg.w);
    }
  }
}

DI void phase_final(float* __restrict__ out, const float* __restrict__ g) {
  const int lane = tid_l() & 63, gw = blockIdx.x * 4 + (tid_l() >> 6), nw = gridDim.x * 4;
  for (int m = gw; m < M_TOT; m += nw) {
    float* xr = out + (size_t)m * DM;
    float4 v[4]; float ss = 0.f;
#pragma unroll
    for (int i = 0; i < 4; ++i) { v[i] = *reinterpret_cast<const float4*>(xr + (i * 64 + lane) * 4); ss += v[i].x * v[i].x + v[i].y * v[i].y + v[i].z * v[i].z + v[i].w * v[i].w; }
    ss = wave_sum(ss);
    const float rs = rsqrtf(ss * (1.f / DM) + EPS);
#pragma unroll
    for (int i = 0; i < 4; ++i) {
      const int c = (i * 64 + lane) * 4; const float4 gg = *reinterpret_cast<const float4*>(g + c);
      float4 o; o.x = v[i].x * rs * gg.x; o.y = v[i].y * rs * gg.y; o.z = v[i].z * rs * gg.z; o.w = v[i].w * rs * gg.w;
      *reinterpret_cast<float4*>(xr + c) = o;
    }
  }
}

DI void phase_even_mid(const Params& p, int li, int hf) {
  char* ws = p.ws;
  const u16* proj = (const u16*)(ws + E_PROJ);
  u16* cqn = (u16*)(ws + E_CQN); u16* ckvn = (u16*)(ws + E_CKVN); u16* kr = (u16*)(ws + E_KR); u16* dp = (u16*)(ws + E_DP);
  const unsigned* tab = (const unsigned*)(ws + OFF_TAB);
  const float* qg = p.a_q_norm_g + li * 384; const float* kvg = p.a_kv_norm_g + li * 128;
  const int lane = tid_l() & 63, gw = blockIdx.x * 4 + (tid_l() >> 6), nw = gridDim.x * 4;
  for (int m = gw; m < MH; m += nw) {
    const u16* pr = proj + (size_t)m * EIN;
    const long mg = (long)hf * MH + m;
    uint4 w = *reinterpret_cast<const uint4*>(pr + lane * 8);
    float f[8] = {bflo(w.x), bfhi(w.x), bflo(w.y), bfhi(w.y), bflo(w.z), bfhi(w.z), bflo(w.w), bfhi(w.w)};
    float ss = 0.f;
#pragma unroll
    for (int j = 0; j < 8; ++j) ss += f[j] * f[j];
    float ssq = wave_sum(lane < 48 ? ss : 0.f), sskv = wave_sum(lane >= 48 ? ss : 0.f);
    const float rq = rsqrtf(ssq * (1.f / 384.f) + EPS), rkv = rsqrtf(sskv * (1.f / 128.f) + EPS);
    if (lane < 48) {
      const float* gp = qg + lane * 8; uint4 o;
      o.x = cvtpk(f[0] * rq * gp[0], f[1] * rq * gp[1]); o.y = cvtpk(f[2] * rq * gp[2], f[3] * rq * gp[3]);
      o.z = cvtpk(f[4] * rq * gp[4], f[5] * rq * gp[5]); o.w = cvtpk(f[6] * rq * gp[6], f[7] * rq * gp[7]);
      *reinterpret_cast<uint4*>(cqn + (size_t)m * 384 + lane * 8) = o;
    } else {
      const int c = (lane - 48) * 8; const float* gp = kvg + c; uint4 o;
      o.x = cvtpk(f[0] * rkv * gp[0], f[1] * rkv * gp[1]); o.y = cvtpk(f[2] * rkv * gp[2], f[3] * rkv * gp[3]);
      o.z = cvtpk(f[4] * rkv * gp[4], f[5] * rkv * gp[5]); o.w = cvtpk(f[6] * rkv * gp[6], f[7] * rkv * gp[7]);
      *reinterpret_cast<uint4*>(ckvn + (size_t)m * 128 + c) = o;
    }
    if (lane < 32) {
      unsigned kw = *reinterpret_cast<const unsigned*>(pr + 512 + lane * 2);
      float x1 = bflo(kw), x2 = bfhi(kw), c, s; rope_cs(tab, mg, 4 * lane, c, s);
      *reinterpret_cast<unsigned*>(kr + (size_t)m * 64 + lane * 2) = cvtpk(x1 * c - x2 * s, x2 * c + x1 * s);
    }
    const int t = m & (TSEQ - 1);
#pragma unroll
    for (int h2 = 0; h2 < 2; ++h2) {
      const int cb = lane * 8 + h2 * 512, g = (lane >> 5) + 2 * h2, wnd = 2 << g, left = wnd >> 1, right = wnd - 1 - left;
      const int lo = max(t - left, 0), hi = min(t + right, TSEQ - 1);
      float a[8] = {0.f, 0.f, 0.f, 0.f, 0.f, 0.f, 0.f, 0.f};
      for (int tt = lo; tt <= hi; ++tt) {
        uint4 u = *reinterpret_cast<const uint4*>(proj + (size_t)(m + tt - t) * EIN + U0 + cb);
        a[0] += bflo(u.x); a[1] += bfhi(u.x); a[2] += bflo(u.y); a[3] += bfhi(u.y); a[4] += bflo(u.z); a[5] += bfhi(u.z); a[6] += bflo(u.w); a[7] += bfhi(u.w);
      }
      const float ic = 1.f / (float)(hi - lo + 1);
      uint4 u = *reinterpret_cast<const uint4*>(pr + U0 + cb); uint4 o;
      o.x = cvtpk(a[0] * ic - bflo(u.x), a[1] * ic - bfhi(u.x)); o.y = cvtpk(a[2] * ic - bflo(u.y), a[3] * ic - bfhi(u.y));
      o.z = cvtpk(a[4] * ic - bflo(u.z), a[5] * ic - bfhi(u.z)); o.w = cvtpk(a[6] * ic - bflo(u.w), a[7] * ic - bfhi(u.w));
      *reinterpret_cast<uint4*>(dp + (size_t)m * 1024 + cb) = o;
    }
  }
}

constexpr int AK_STRIDE = 400, AV_STRIDE = 136, AK_BYTES = 64 * AK_STRIDE;
DI void attn_item(const u16* __restrict__ q, const u16* __restrict__ kn, const u16* __restrict__ kr, const u16* __restrict__ vT,
                  const u16* __restrict__ proj, u16* __restrict__ y, int item, char* lds) {
  const int qb = item & 15, head = (item >> 4) & 7, bl = item >> 7;
  const int tid = tid_l(), lane = tid & 63, wave = tid >> 6, l31 = lane & 31, hi = lane >> 5;
  const int qrow = bl * TSEQ + qb * 128 + wave * 32 + l31;
  char* Ks = lds; char* Vs = lds + AK_BYTES;
  bf16x8 qf[12];
#pragma unroll
  for (int dd = 0; dd < 12; ++dd) qf[dd] = *reinterpret_cast<const bf16x8*>(q + (size_t)qrow * 1536 + head * 192 + dd * 16 + hi * 8);
  f32x16 o[4];
#pragma unroll
  for (int d = 0; d < 4; ++d)
#pragma unroll
    for (int r = 0; r < 16; ++r) o[d][r] = 0.f;
  float mrow = -1e30f, lsum = 0.f;
  constexpr float C = 0.07216878364870322f * 1.4426950408889634f;
  const u16* knsrc = kn + (size_t)(bl * TSEQ + (tid >> 4)) * 1024 + head * 128 + (tid & 15) * 8;
  const u16* krsrc = kr + (size_t)(bl * TSEQ + (tid >> 3)) * 64 + (tid & 7) * 8;
  const int kndst = (tid >> 4) * AK_STRIDE + (tid & 15) * 16, krdst = (tid >> 3) * AK_STRIDE + 256 + (tid & 7) * 16;
  const u16* vsrc = vT + ((size_t)(bl * 8 + head) * 128 + (tid >> 3)) * TSEQ + (tid & 7) * 8;
  const int vdst = (tid >> 3) * AV_STRIDE + (tid & 7) * 16;
  u32x4 kst[6], vst[4];
#pragma unroll
  for (int i = 0; i < 4; ++i) kst[i] = *reinterpret_cast<const u32x4*>(knsrc + (size_t)(16 * i) * 1024);
#pragma unroll
  for (int i = 0; i < 2; ++i) kst[4 + i] = *reinterpret_cast<const u32x4*>(krsrc + (size_t)(32 * i) * 64);
#pragma unroll
  for (int i = 0; i < 4; ++i) vst[i] = *reinterpret_cast<const u32x4*>(vsrc + (size_t)(32 * i) * TSEQ);
#pragma unroll
  for (int i = 0; i < 4; ++i) *reinterpret_cast<u32x4*>(Ks + kndst + 16 * i * AK_STRIDE) = kst[i];
#pragma unroll
  for (int i = 0; i < 2; ++i) *reinterpret_cast<u32x4*>(Ks + krdst + 32 * i * AK_STRIDE) = kst[4 + i];
#pragma unroll
  for (int i = 0; i < 4; ++i) { u32x2* d = reinterpret_cast<u32x2*>(Vs + vdst + 32 * i * AV_STRIDE); d[0] = u32x2{vst[i][0], vst[i][1]}; d[1] = u32x2{vst[i][2], vst[i][3]}; }
  __syncthreads();
  const char* kf = Ks + l31 * AK_STRIDE + hi * 16;
  const char* vf = Vs + l31 * AV_STRIDE + hi * 8;
  for (int j = 0; j < 32; ++j) {
    if (j + 1 < 32) {
#pragma unroll
      for (int i = 0; i < 4; ++i) kst[i] = *reinterpret_cast<const u32x4*>(knsrc + (size_t)((j + 1) * 64 + 16 * i) * 1024);
#pragma unroll
      for (int i = 0; i < 2; ++i) kst[4 + i] = *reinterpret_cast<const u32x4*>(krsrc + (size_t)((j + 1) * 64 + 32 * i) * 64);
#pragma unroll
      for (int i = 0; i < 4; ++i) vst[i] = *reinterpret_cast<const u32x4*>(vsrc + (size_t)(32 * i) * TSEQ + (j + 1) * 64);
    }
    f32x16 p0, p1;
#pragma unroll
    for (int r = 0; r < 16; ++r) { p0[r] = 0.f; p1[r] = 0.f; }
#pragma unroll
    for (int dd = 0; dd < 12; ++dd) {
      bf16x8 a0 = *reinterpret_cast<const bf16x8*>(kf + dd * 32);
      bf16x8 a1 = *reinterpret_cast<const bf16x8*>(kf + 32 * AK_STRIDE + dd * 32);
      p0 = MFMA32(a0, qf[dd], p0);
      p1 = MFMA32(a1, qf[dd], p1);
    }
    float mx = p0[0];
#pragma unroll
    for (int r = 1; r < 16; ++r) mx = fmaxf(mx, p0[r]);
#pragma unroll
    for (int r = 0; r < 16; ++r) mx = fmaxf(mx, p1[r]);
    mx = fmaxf(mx, __shfl_xor(mx, 32, 64));
    const float mnew = fmaxf(mrow, mx);
    const float alpha = exp2f((mrow - mnew) * C);
    mrow = mnew;
    const float mc = -mnew * C;
    float ps = 0.f;
#pragma unroll
    for (int r = 0; r < 16; ++r) { p0[r] = exp2f(fmaf(p0[r], C, mc)); ps += p0[r]; }
#pragma unroll
    for (int r = 0; r < 16; ++r) { p1[r] = exp2f(fmaf(p1[r], C, mc)); ps += p1[r]; }
    lsum = lsum * alpha + ps;
#pragma unroll
    for (int d = 0; d < 4; ++d)
#pragma unroll
      for (int r = 0; r < 16; ++r) o[d][r] *= alpha;
    bf16x8 pf[4];
#pragma unroll
    for (int s = 0; s < 2; ++s) {
      unsigned w0 = cvtpk(p0[8 * s], p0[8 * s + 1]), w1 = cvtpk(p0[8 * s + 2], p0[8 * s + 3]), w2 = cvtpk(p0[8 * s + 4], p0[8 * s + 5]), w3 = cvtpk(p0[8 * s + 6], p0[8 * s + 7]);
      u32x4 u = {w0, w1, w2, w3}; pf[s] = __builtin_bit_cast(bf16x8, u);
      unsigned x0 = cvtpk(p1[8 * s], p1[8 * s + 1]), x1 = cvtpk(p1[8 * s + 2], p1[8 * s + 3]), x2 = cvtpk(p1[8 * s + 4], p1[8 * s + 5]), x3 = cvtpk(p1[8 * s + 6], p1[8 * s + 7]);
      u32x4 u2 = {x0, x1, x2, x3}; pf[2 + s] = __builtin_bit_cast(bf16x8, u2);
    }
#pragma unroll
    for (int s = 0; s < 4; ++s)
#pragma unroll
      for (int db = 0; db < 4; ++db) {
        const s16x4 lo4 = *reinterpret_cast<const s16x4*>(vf + db * 32 * AV_STRIDE + s * 32);
        const s16x4 hi4 = *reinterpret_cast<const s16x4*>(vf + db * 32 * AV_STRIDE + s * 32 + 16);
        const bf16x8 vfrag = __builtin_shufflevector(lo4, hi4, 0, 1, 2, 3, 4, 5, 6, 7);
        o[db] = MFMA32(vfrag, pf[s], o[db]);
      }
    __syncthreads();
    if (j + 1 < 32) {
#pragma unroll
      for (int i = 0; i < 4; ++i) *reinterpret_cast<u32x4*>(Ks + kndst + 16 * i * AK_STRIDE) = kst[i];
#pragma unroll
      for (int i = 0; i < 2; ++i) *reinterpret_cast<u32x4*>(Ks + krdst + 32 * i * AK_STRIDE) = kst[4 + i];
#pragma unroll
      for (int i = 0; i < 4; ++i) { u32x2* d = reinterpret_cast<u32x2*>(Vs + vdst + 32 * i * AV_STRIDE); d[0] = u32x2{vst[i][0], vst[i][1]}; d[1] = u32x2{vst[i][2], vst[i][3]}; }
    }
    __syncthreads();
  }
  lsum += __shfl_xor(lsum, 32, 64);
  const float inv = 1.f / lsum;
#pragma unroll
  for (int db = 0; db < 4; ++db)
#pragma unroll
    for (int g = 0; g < 4; ++g) {
      const int d = db * 32 + 8 * g + 4 * hi;
      float g0, g1, g2, g3; load4bf(proj + (size_t)qrow * EIN + GATE0 + head * 128 + d, g0, g1, g2, g3);
      store4bf(y + (size_t)qrow * 2048 + head * 128 + d, o[db][4 * g] * inv * silu(g0), o[db][4 * g + 1] * inv * silu(g1), o[db][4 * g + 2] * inv * silu(g2), o[db][4 * g + 3] * inv * silu(g3));
    }
}

template <int PH>
DI void run_phase(const Params& p, int layer, int hf, char* lds) {
  char* ws = p.ws;
  asm volatile("" : "+s"(ws));
  const int nb = gridDim.x, bid = blockIdx.x, li = layer >> 1;
  const float* xin = (layer == 0 && (DBG_MASK & 1)) ? p.x : p.out;
  const unsigned* tab = (const unsigned*)(ws + OFF_TAB);
  (void)nb; (void)bid; (void)li; (void)xin; (void)tab;
  if constexpr (PH == 0) { phase_prep(p, lds); }
  else if constexpr (PH == 14) { phase_final(p.out, p.final_norm_g); }
  else if constexpr (PH == 16) {
    const u16* b0 = (const u16*)(ws + O_Q); const u16* b1 = (const u16*)(ws + O_K); const u16* b2 = (const u16*)(ws + O_KFT); const u16* b3 = (const u16*)(ws + O_KBT);
    const u16* b4 = (const u16*)(ws + O_VT); const u16* b5 = (const u16*)(ws + O_GATE); const u16* b6 = (const u16*)(ws + O_P); const u16* b7 = (const u16*)(ws + O_O);
    const size_t n64 = 32ull << 20, n128 = 64ull << 20, n32 = 16ull << 20;
    for (size_t e = (size_t)bid * NTHR + tid_l(); e < (size_t)M_TOT * DM; e += (size_t)nb * NTHR) {
      float v = 0.f;
      if (layer == 1) v = bf2f(b0[e % n64]) + bf2f(b1[e % n64]) + bf2f(b2[e % n64]) + bf2f(b3[e % n64]) + bf2f(b4[e % n128]) + bf2f(b5[e % n128]);
      if (layer == 2) v = bf2f(b6[e % n32]);
      if (layer >= 3) v = bf2f(b7[e % n128]);
      p.out[e] = v;
    }
  }
  else if constexpr (PH == 15) {
    const float4* src = reinterpret_cast<const float4*>(p.x); float4* dst = reinterpret_cast<float4*>(p.out);
    for (size_t e = (size_t)bid * NTHR + tid_l(); e < (size_t)M_TOT * DM / 4; e += (size_t)nb * NTHR) dst[e] = src[e];
  }
  else if constexpr (PH >= 1 && PH <= 6) {
        u16* h = (u16*)(ws + E_H); u16* proj = (u16*)(ws + E_PROJ); u16* cqn = (u16*)(ws + E_CQN); u16* ckvn = (u16*)(ws + E_CKVN); u16* kr = (u16*)(ws + E_KR);
        u16* dp = (u16*)(ws + E_DP); u16* q = (u16*)(ws + E_Q); u16* kn = (u16*)(ws + E_KN); u16* vT = (u16*)(ws + E_VT); u16* y = (u16*)(ws + E_Y);
        const u16* winT = (const u16*)(ws + OFF_A_WIN + li * SZ_A_WIN); const u16* wuqT = (const u16*)(ws + OFF_A_WUQ + li * SZ_A_WUQ);
        const u16* wukvT = (const u16*)(ws + OFF_A_WUKV + li * SZ_A_WUKV); const u16* poolT = (const u16*)(ws + OFF_A_POOL + li * SZ_A_POOL);
        const u16* woutT = (const u16*)(ws + OFF_A_WOUT + li * SZ_A_WOUT);
        if constexpr (PH == 1) {
        phase_rownorm(xin, p.a_norm_g + li * DM, h, hf);
        }
        if constexpr (PH == 2) {
        for (int tile = bid; tile < 256 * 29; tile += nb) {
          const int mt = tile / 29, nt = tile - mt * 29, m0 = mt * 128, n0 = nt * 128;
          gemm_tile(h + (size_t)m0 * DM, DM, winT + (size_t)n0 * DM, DM, DM, lds, [=](int m, int n, float v0, float v1, float v2, float v3) {
            if (n0 + n < EIN) store4bf(proj + (size_t)(m0 + m) * EIN + n0 + n, v0, v1, v2, v3);
          });
        }
        }
        if constexpr (PH == 3) {
        phase_even_mid(p, li, hf);
        }
        if constexpr (PH == 4) {
        for (int tile = bid; tile < 256 * 36; tile += nb) {
          const int mt = tile / 36, nt = tile - mt * 36, m0 = mt * 128;
          if (nt < 12) {
            const int n0 = nt * 128;
            gemm_tile(cqn + (size_t)m0 * 384, 384, wuqT + (size_t)n0 * 384, 384, 384, lds, [=](int m, int n, float v0, float v1, float v2, float v3) {
              const int nn = n0 + n, w = nn % 192;
              if (w >= 128) {
                const long mg = (long)hf * MH + m0 + m; const int pi = (w - 128) >> 1; float c0, s0, c1, s1;
                rope_cs(tab, mg, 4 * pi, c0, s0); rope_cs(tab, mg, 4 * pi + 4, c1, s1);
                const float a = v0 * c0 - v1 * s0, b = v1 * c0 + v0 * s0, c = v2 * c1 - v3 * s1, d = v3 * c1 + v2 * s1;
                v0 = a; v1 = b; v2 = c; v3 = d;
              }
              store4bf(q + (size_t)(m0 + m) * 1536 + nn, v0, v1, v2, v3);
            });
          } else if (nt < 28) {
            const int n0 = (nt - 12) * 128;
            gemm_tile(ckvn + (size_t)m0 * 128, 128, wukvT + (size_t)n0 * 128, 128, 128, lds, [=](int m, int n, float v0, float v1, float v2, float v3) {
              const int nn = n0 + n, head = nn >> 8, w = nn & 255, mm = m0 + m;
              if (w < 128) store4bf(kn + (size_t)mm * 1024 + head * 128 + w, v0, v1, v2, v3);
              else {
                u16* d = vT + ((size_t)((mm >> 11) * 8 + head) * 128 + (w - 128)) * TSEQ + (mm & (TSEQ - 1));
                d[0] = f2bf(v0); d[TSEQ] = f2bf(v1); d[2 * TSEQ] = f2bf(v2); d[3 * TSEQ] = f2bf(v3);
              }
            });
          } else {
            const int pt = nt - 28, g = pt >> 1, n0 = pt * 128;
            const float* psc = p.a_pool_scale + li * 1024;
            gemm_tile(dp + (size_t)m0 * 1024 + g * 256, 1024, poolT + (size_t)n0 * 256, 256, 256, lds, [=](int m, int n, float v0, float v1, float v2, float v3) {
              const int nn = n0 + n, mm = m0 + m; float g0, g1, g2, g3;
              load4bf(proj + (size_t)mm * EIN + GATE0 + 1024 + nn, g0, g1, g2, g3);
              const float4 sc = *reinterpret_cast<const float4*>(psc + nn);
              store4bf(y + (size_t)mm * 2048 + 1024 + nn, v0 * sc.x * silu(g0), v1 * sc.y * silu(g1), v2 * sc.z * silu(g2), v3 * sc.w * silu(g3));
            });
          }
        }
        }
        if constexpr (PH == 5) {
                for (int item = bid; item < 2048; item += nb) attn_item(q, kn, kr, vT, proj, y, item, lds);
        }
        if constexpr (PH == 6) {
        for (int tile = bid; tile < 256 * 8; tile += nb) {
          const int mt = tile >> 3, nt = tile & 7, m0 = mt * 128, n0 = nt * 128;
          float* outp = p.out;
          gemm_tile(y + (size_t)m0 * 2048, 2048, woutT + (size_t)n0 * 2048, 2048, 2048, lds, [=](int m, int n, float v0, float v1, float v2, float v3) {
            const size_t idx = ((size_t)hf * MH + m0 + m) * DM + n0 + n;
            const float4 xr = *reinterpret_cast<const float4*>(xin + idx);
            float4 o; o.x = xr.x + v0; o.y = xr.y + v1; o.z = xr.z + v2; o.w = xr.w + v3;
            *reinterpret_cast<float4*>(outp + idx) = o;
          });
        }
        }
  } else {
        u16* h = (u16*)(ws + O_H); u16* q = (u16*)(ws + O_Q); u16* k = (u16*)(ws + O_K); u16* kfT = (u16*)(ws + O_KFT); u16* kbT = (u16*)(ws + O_KBT);
        u16* vT = (u16*)(ws + O_VT); u16* gate = (u16*)(ws + O_GATE); u16* ob = (u16*)(ws + O_O); u16* P = (u16*)(ws + O_P);
        float* SF = (float*)(ws + O_SF); u16* SB = (u16*)(ws + O_SB);
        const u16* winT = (const u16*)(ws + OFF_R_WIN + li * SZ_R_WIN); const u16* woutT = (const u16*)(ws + OFF_R_WOUT + li * SZ_R_WOUT);
        float lf[4], lb[4];
#pragma unroll
        for (int i = 0; i < 4; ++i) { lf[i] = log_sigmoid(p.r_decay_fwd[li * 4 + i]); lb[i] = log_sigmoid(p.r_decay_bwd[li * 4 + i]); }
        if constexpr (PH == 7) {
        phase_rownorm(xin, p.r_norm_g + li * DM, h, hf);
        }
        if constexpr (PH == 8) {
        for (int tile = bid; tile < 256 * 48; tile += nb) {
          const int mt = tile / 48, nt = tile - mt * 48, m0 = mt * 128, n0 = nt * 128;
          const int head4 = (nt >> 1) & 3;
          const float lfh = head4 == 0 ? lf[0] : head4 == 1 ? lf[1] : head4 == 2 ? lf[2] : lf[3];
          const float lbh = head4 == 0 ? lb[0] : head4 == 1 ? lb[1] : head4 == 2 ? lb[2] : lb[3];
          gemm_tile(h + (size_t)m0 * DM, DM, winT + (size_t)n0 * DM, DM, DM, lds, [=](int m, int n, float v0, float v1, float v2, float v3) {
            const int nn = n0 + n, mm = m0 + m;
            if (nn < 2048) {
              const long mg = (long)hf * MH + mm; const int pi = (nn & 255) >> 1; float c0, s0, c1, s1;
              rope_cs(tab, mg, pi, c0, s0); rope_cs(tab, mg, pi + 1, c1, s1);
              float a = v0 * c0 - v1 * s0, b = v1 * c0 + v0 * s0, c = v2 * c1 - v3 * s1, d = v3 * c1 + v2 * s1;
              if (nn < 1024) store4bf(q + (size_t)mm * 1024 + nn, a, b, c, d);
              else {
                a *= 0.0625f; b *= 0.0625f; c *= 0.0625f; d *= 0.0625f;
                const int kc = nn - 1024;
                store4bf(k + (size_t)mm * 1024 + kc, a, b, c, d);
                const int t = mm & (TSEQ - 1), j = t & 127;
                const float zf = __expf((float)(127 - j) * lfh), zb = __expf((float)j * lbh);
                const size_t base = ((size_t)((mm >> 11) * 4 + (kc >> 8)) * 256 + (kc & 255)) * TSEQ + t;
                kfT[base] = f2bf(a * zf); kfT[base + TSEQ] = f2bf(b * zf); kfT[base + 2 * TSEQ] = f2bf(c * zf); kfT[base + 3 * TSEQ] = f2bf(d * zf);
                kbT[base] = f2bf(a * zb); kbT[base + TSEQ] = f2bf(b * zb); kbT[base + 2 * TSEQ] = f2bf(c * zb); kbT[base + 3 * TSEQ] = f2bf(d * zb);
              }
            } else if (nn < 4096) {
              const int vc = nn - 2048;
              const size_t base = ((size_t)((mm >> 11) * 4 + (vc >> 9)) * 512 + (vc & 511)) * TSEQ + (mm & (TSEQ - 1));
              vT[base] = f2bf(v0); vT[base + TSEQ] = f2bf(v1); vT[base + 2 * TSEQ] = f2bf(v2); vT[base + 3 * TSEQ] = f2bf(v3);
            } else {
              store4bf(gate + (size_t)mm * 2048 + nn - 4096, v0, v1, v2, v3);
            }
          });
        }
        }
        if constexpr (PH == 9) {
        for (int item = bid; item < 1024; item += nb) {
          const int c = item & 15, hd = (item >> 4) & 3, bl = item >> 6;
          const size_t r0 = (size_t)(bl * TSEQ + c * 128) * 1024 + hd * 256;
          const float lfh = hd == 0 ? lf[0] : hd == 1 ? lf[1] : hd == 2 ? lf[2] : lf[3];
          const float lbh = hd == 0 ? lb[0] : hd == 1 ? lb[1] : hd == 2 ? lb[2] : lb[3];
          u16* Pi = P + (size_t)item * 16384;
          gemm_tile(q + r0, 1024, k + r0, 1024, 256, lds, [=](int m, int n, float v0, float v1, float v2, float v3) {
            float v[4] = {v0, v1, v2, v3};
#pragma unroll
            for (int e = 0; e < 4; ++e) { const int d = m - (n + e); v[e] *= d >= 0 ? __expf((float)d * lfh) : __expf((float)(-d) * lbh); }
            store4bf(Pi + m * 128 + n, v[0], v[1], v[2], v[3]);
          });
        }
        }
        if constexpr (PH == 10) {
        for (int tile = bid; tile < 4096; tile += nb) {
          const int nt = tile & 3, item = tile >> 2, c = item & 15, hd = (item >> 4) & 3, bl = item >> 6;
          const u16* Pi = P + (size_t)item * 16384;
          const u16* vb = vT + ((size_t)(bl * 4 + hd) * 512 + nt * 128) * TSEQ + c * 128;
          u16* od = ob + (size_t)(bl * TSEQ + c * 128) * 2048 + hd * 512 + nt * 128;
          gemm_tile(Pi, 128, vb, TSEQ, 128, lds, [=](int m, int n, float v0, float v1, float v2, float v3) {
            store4bf(od + (size_t)m * 2048 + n, v0, v1, v2, v3);
          });
        }
        }
        if constexpr (PH == 11) {
        for (int item = bid; item < 256; item += nb) {
          const int vs = item & 3, hd = (item >> 2) & 3, bl = item >> 4;
          const float lfh = hd == 0 ? lf[0] : hd == 1 ? lf[1] : hd == 2 ? lf[2] : lf[3];
          const float lbh = hd == 0 ? lb[0] : hd == 1 ? lb[1] : hd == 2 ? lb[2] : lb[3];
          float* Sf = SF + (size_t)item * 32768; u16* Sb = SB + (size_t)item * 32768;
          const u16* va = vT + ((size_t)(bl * 4 + hd) * 512 + vs * 128) * TSEQ;
          for (int dir = 0; dir < 2; ++dir) {
            const float lg = dir ? lfh : lbh;
            const float cdec = __expf(128.f * lg);
            const u16* kT = (dir ? kfT : kbT) + (size_t)(bl * 4 + hd) * 256 * TSEQ;
            for (int step = 0; step < 16; ++step) {
              const int c = dir ? step : 15 - step;
              if (step > 0) {
                u16* od = ob + (size_t)(bl * TSEQ + c * 128) * 2048 + hd * 512 + vs * 128;
                gemm_tile(q + (size_t)(bl * TSEQ + c * 128) * 1024 + hd * 256, 1024, Sb, 256, 256, lds, [=](int m, int n, float v0, float v1, float v2, float v3) {
                  const float xi = dir ? __expf((float)(m + 1) * lg) : __expf((float)(128 - m) * lg);
                  float o0, o1, o2, o3; u16* op = od + (size_t)m * 2048 + n; load4bf(op, o0, o1, o2, o3);
                  store4bf(op, o0 + v0 * xi, o1 + v1 * xi, o2 + v2 * xi, o3 + v3 * xi);
                });
              }
              if (step < 15) {
                for (int dt = 0; dt < 2; ++dt) {
                  gemm_tile(va + c * 128, TSEQ, kT + (size_t)(dt * 128) * TSEQ + c * 128, TSEQ, 128, lds, [=](int m, int n, float v0, float v1, float v2, float v3) {
                    float* sp = Sf + m * 256 + dt * 128 + n;
                    if (step > 0) { const float4 s = *reinterpret_cast<const float4*>(sp); v0 += cdec * s.x; v1 += cdec * s.y; v2 += cdec * s.z; v3 += cdec * s.w; }
                    float4 o; o.x = v0; o.y = v1; o.z = v2; o.w = v3; *reinterpret_cast<float4*>(sp) = o;
                    store4bf(Sb + m * 256 + dt * 128 + n, v0, v1, v2, v3);
                  });
                }
              }
              __threadfence(); __syncthreads(); __threadfence();
            }
          }
        }
        }
        if constexpr (PH == 12) {
        {
          const float* gn = p.r_gn_g + li * 2048;
          const int lane = tid_l() & 63, gw = bid * 4 + (tid_l() >> 6), nw = nb * 4;
          for (int row = gw; row < MH * 4; row += nw) {
            const int m = row >> 2, hd = row & 3; const size_t off = (size_t)m * 2048 + hd * 512 + lane * 8;
            uint4 w = *reinterpret_cast<const uint4*>(ob + off);
            float f[8] = {bflo(w.x), bfhi(w.x), bflo(w.y), bfhi(w.y), bflo(w.z), bfhi(w.z), bflo(w.w), bfhi(w.w)};
            float s = 0.f;
#pragma unroll
            for (int j = 0; j < 8; ++j) s += f[j];
            const float mu = wave_sum(s) * (1.f / 512.f);
            float vv = 0.f;
#pragma unroll
            for (int j = 0; j < 8; ++j) { f[j] -= mu; vv += f[j] * f[j]; }
            const float rs = rsqrtf(wave_sum(vv) * (1.f / 512.f) + EPS);
            uint4 gw4 = *reinterpret_cast<const uint4*>(gate + off);
            float gg[8] = {bflo(gw4.x), bfhi(gw4.x), bflo(gw4.y), bfhi(gw4.y), bflo(gw4.z), bfhi(gw4.z), bflo(gw4.w), bfhi(gw4.w)};
            const float* gp = gn + hd * 512 + lane * 8;
            float r[8];
#pragma unroll
            for (int j = 0; j < 8; ++j) r[j] = f[j] * rs * gp[j] * silu(gg[j]);
            uint4 o; o.x = cvtpk(r[0], r[1]); o.y = cvtpk(r[2], r[3]); o.z = cvtpk(r[4], r[5]); o.w = cvtpk(r[6], r[7]);
            *reinterpret_cast<uint4*>(ob + off) = o;
          }
        }
        }
        if constexpr (PH == 13) {
        for (int tile = bid; tile < 256 * 8; tile += nb) {
          const int mt = tile >> 3, nt = tile & 7, m0 = mt * 128, n0 = nt * 128;
          float* outp = p.out;
          gemm_tile(ob + (size_t)m0 * 2048, 2048, woutT + (size_t)n0 * 2048, 2048, 2048, lds, [=](int m, int n, float v0, float v1, float v2, float v3) {
            const size_t idx = ((size_t)hf * MH + m0 + m) * DM + n0 + n;
            const float4 xr = *reinterpret_cast<const float4*>(xin + idx);
            float4 o; o.x = xr.x + v0; o.y = xr.y + v1; o.z = xr.z + v2; o.w = xr.w + v3;
            *reinterpret_cast<float4*>(outp + idx) = o;
          });
        }
        }
  }
}

#ifndef DBG_MASK
#define DBG_MASK 15
#endif
#ifndef N_LAUNCH_PER_PHASE
#define N_LAUNCH_PER_PHASE 0
#endif

#if N_LAUNCH_PER_PHASE
template <int PH>
__global__ void __launch_bounds__(NTHR, 2) k_phase(Params p, int layer, int hf) {
  extern __shared__ __attribute__((aligned(16))) char lds[];
  run_phase<PH>(p, layer, hf, lds);
}
#else
__global__ void __launch_bounds__(NTHR, 2) fwd_megakernel(Params p) {
  extern __shared__ __attribute__((aligned(16))) char lds[];
  cg::grid_group grid = cg::this_grid();
  run_phase<0>(p, 0, 0, lds);
  grid.sync();
  for (int layer = 0; layer < 4; ++layer) {
    for (int hf = 0; hf < 2; ++hf) {
      if ((layer & 1) == 0) {
        run_phase<1>(p, layer, hf, lds); grid.sync();
        run_phase<2>(p, layer, hf, lds); grid.sync();
        run_phase<3>(p, layer, hf, lds); grid.sync();
        run_phase<4>(p, layer, hf, lds); grid.sync();
        run_phase<5>(p, layer, hf, lds); grid.sync();
        run_phase<6>(p, layer, hf, lds); grid.sync();
      } else {
        run_phase<7>(p, layer, hf, lds); grid.sync();
        run_phase<8>(p, layer, hf, lds); grid.sync();
        run_phase<9>(p, layer, hf, lds); grid.sync();
        run_phase<10>(p, layer, hf, lds); grid.sync();
        run_phase<11>(p, layer, hf, lds); grid.sync();
        run_phase<12>(p, layer, hf, lds); grid.sync();
        run_phase<13>(p, layer, hf, lds); grid.sync();
      }
    }
  }
  run_phase<14>(p, 0, 0, lds);
}
#endif

#if N_LAUNCH_PER_PHASE
template <int PH>
static void launch_phase(const Params& p, int layer, int hf, int grid, hipStream_t stream) {
  static bool attr = false;
  if (!attr) { (void)hipFuncSetAttribute((const void*)k_phase<PH>, hipFuncAttributeMaxDynamicSharedMemorySize, LDS_BYTES); attr = true; }
  hipLaunchKernelGGL(k_phase<PH>, dim3(grid), dim3(NTHR), LDS_BYTES, stream, p, layer, hf);
}
#endif

extern "C" void kernel_launch(void* const* d_in, const int* in_sizes, int n_in, void* d_out, int out_size, void* d_ws, size_t ws_size, hipStream_t stream) {
  static int grid_blocks = 0;
  if (grid_blocks == 0) {
    if (n_in != 18 || ws_size < WS_NEED) { fprintf(stderr, "kernel_launch: n_in %d ws %zu need %zu\n", n_in, ws_size, (size_t)WS_NEED); grid_blocks = -1; return; }
    int dev = 0, cus = 0;
    (void)hipGetDevice(&dev);
    (void)hipDeviceGetAttribute(&cus, hipDeviceAttributeMultiprocessorCount, dev);
#if N_LAUNCH_PER_PHASE
    grid_blocks = cus * 2;
#else
    int per_cu = 0;
    if (hipFuncSetAttribute((const void*)fwd_megakernel, hipFuncAttributeMaxDynamicSharedMemorySize, LDS_BYTES) != hipSuccess) { fprintf(stderr, "hipFuncSetAttribute failed\n"); grid_blocks = -1; return; }
    if (hipOccupancyMaxActiveBlocksPerMultiprocessor(&per_cu, (const void*)fwd_megakernel, NTHR, LDS_BYTES) != hipSuccess || per_cu < 1) { fprintf(stderr, "occupancy query failed\n"); grid_blocks = -1; return; }
    if (per_cu > 2) per_cu = 2;
    grid_blocks = cus * per_cu;
#endif
  }
  if (grid_blocks < 0) return;
  Params p{};
  p.x = (const float*)d_in[0]; p.pos = (const int*)d_in[1];
  p.a_norm_g = (const float*)d_in[2]; p.a_w_in = (const float*)d_in[3]; p.a_q_norm_g = (const float*)d_in[4]; p.a_w_uq = (const float*)d_in[5];
  p.a_kv_norm_g = (const float*)d_in[6]; p.a_w_ukv = (const float*)d_in[7]; p.a_pool_w = (const float*)d_in[8]; p.a_pool_scale = (const float*)d_in[9];
  p.a_w_out = (const float*)d_in[10]; p.r_norm_g = (const float*)d_in[11]; p.r_w_in = (const float*)d_in[12]; p.r_decay_fwd = (const float*)d_in[13];
  p.r_decay_bwd = (const float*)d_in[14]; p.r_gn_g = (const float*)d_in[15]; p.r_w_out = (const float*)d_in[16]; p.final_norm_g = (const float*)d_in[17];
  p.out = (float*)d_out; p.ws = (char*)d_ws;
#if N_LAUNCH_PER_PHASE
  const int g = grid_blocks;
#ifdef DBG_STAGE
  launch_phase<0>(p, 0, 0, g, stream);
  launch_phase<15>(p, 0, 0, g, stream);
  launch_phase<7>(p, 1, 0, g, stream); launch_phase<8>(p, 1, 0, g, stream);
  if (DBG_STAGE >= 2) launch_phase<9>(p, 1, 0, g, stream);
  if (DBG_STAGE >= 3) launch_phase<10>(p, 1, 0, g, stream);
  if (DBG_STAGE >= 4) launch_phase<12>(p, 1, 0, g, stream);
  launch_phase<16>(p, DBG_STAGE, 0, g, stream);
#else
  launch_phase<0>(p, 0, 0, g, stream);
  if (!(DBG_MASK & 1)) launch_phase<15>(p, 0, 0, g, stream);
  for (int layer = 0; layer < 4; ++layer)
    for (int hf = 0; hf < 2; ++hf) {
      if (!((DBG_MASK >> layer) & 1)) continue;
      if ((layer & 1) == 0) {
        launch_phase<1>(p, layer, hf, g, stream); launch_phase<2>(p, layer, hf, g, stream); launch_phase<3>(p, layer, hf, g, stream);
        launch_phase<4>(p, layer, hf, g, stream); launch_phase<5>(p, layer, hf, g, stream); launch_phase<6>(p, layer, hf, g, stream);
      } else {
        launch_phase<7>(p, layer, hf, g, stream); launch_phase<8>(p, layer, hf, g, stream); launch_phase<9>(p, layer, hf, g, stream);
        launch_phase<10>(p, layer, hf, g, stream);
#ifndef DBG_SKIP_SCAN
        launch_phase<11>(p, layer, hf, g, stream);
#endif
        launch_phase<12>(p, layer, hf, g, stream);
        launch_phase<13>(p, layer, hf, g, stream);
      }
    }
  launch_phase<14>(p, 0, 0, g, stream);
#endif
#else
  void* args[] = {&p};
  hipError_t e = hipLaunchCooperativeKernel((const void*)fwd_megakernel, dim3(grid_blocks), dim3(NTHR), args, LDS_BYTES, stream);
  if (e != hipSuccess) fprintf(stderr, "cooperative launch failed: %s (grid %d)\n", hipGetErrorString(e), grid_blocks);
#endif
}
```

```cpp
#include <hip/hip_runtime.h>
#include <hip/hip_cooperative_groups.h>
#include <hip/hip_fp16.h>
#include <cstdio>
namespace cg = cooperative_groups;
#ifndef DBG_MASK
#define DBG_MASK 15
#endif

typedef unsigned short u16;
using bf16x8 = __attribute__((ext_vector_type(8))) short;
using s16x4  = __attribute__((ext_vector_type(4))) short;
using f32x16 = __attribute__((ext_vector_type(16))) float;
using u32x4 = __attribute__((ext_vector_type(4))) unsigned;
using u32x2 = __attribute__((ext_vector_type(2))) unsigned;
#define DI __device__ __forceinline__
DI int tid_l() { int t = threadIdx.x; asm volatile("" : "+v"(t)); return t; }
#define MFMA32(a, b, c) __builtin_amdgcn_mfma_f32_32x32x16_bf16((a), (b), (c), 0, 0, 0)

constexpr int M_TOT = 65536, MH = 32768, TSEQ = 2048, DM = 1024;
constexpr int EIN = 3648, EIN_PAD = 3712, GATE0 = 1600, U0 = 576;
constexpr int NTHR = 256;
constexpr float EPS = 1e-6f;

constexpr size_t MiB = 1024ull * 1024ull;
constexpr size_t SZ_A_WIN = (size_t)EIN_PAD * 1024 * 2, SZ_A_WUQ = 1536ull * 384 * 2, SZ_A_WUKV = 2048ull * 128 * 2, SZ_A_POOL = 4ull * 256 * 256 * 2,
                 SZ_A_WOUT = 1024ull * 2048 * 2, SZ_R_WIN = 6144ull * 1024 * 2, SZ_R_WOUT = 1024ull * 2048 * 2;
constexpr size_t OFF_A_WIN = 0, OFF_A_WUQ = OFF_A_WIN + 2 * SZ_A_WIN, OFF_A_WUKV = OFF_A_WUQ + 2 * SZ_A_WUQ, OFF_A_POOL = OFF_A_WUKV + 2 * SZ_A_WUKV,
                 OFF_A_WOUT = OFF_A_POOL + 2 * SZ_A_POOL, OFF_R_WIN = OFF_A_WOUT + 2 * SZ_A_WOUT, OFF_R_WOUT = OFF_R_WIN + 2 * SZ_R_WIN,
                 OFF_TAB = OFF_R_WOUT + 2 * SZ_R_WOUT, OFF_ACT = ((OFF_TAB + (size_t)M_TOT * 128 * 4 + 255) / 256) * 256;
constexpr size_t E_H = OFF_ACT, E_PROJ = E_H + 64 * MiB, E_CQN = E_PROJ + (size_t)MH * EIN * 2, E_CKVN = E_CQN + 24 * MiB, E_KR = E_CKVN + 8 * MiB,
                 E_DP = E_KR + 4 * MiB, E_Q = E_DP + 64 * MiB, E_KN = E_Q + 96 * MiB, E_VT = E_KN + 64 * MiB, E_Y = E_VT + 64 * MiB, E_END = E_Y + 128 * MiB;
constexpr size_t O_H = OFF_ACT, O_Q = O_H + 64 * MiB, O_K = O_Q + 64 * MiB, O_KFT = O_K + 64 * MiB, O_KBT = O_KFT + 64 * MiB, O_VT = O_KBT + 64 * MiB,
                 O_GATE = O_VT + 128 * MiB, O_O = O_GATE + 128 * MiB, O_P = O_O + 128 * MiB, O_SF = O_P + 32 * MiB, O_SB = O_SF + 32 * MiB, O_END = O_SB + 16 * MiB;
constexpr size_t WS_NEED = E_END > O_END ? E_END : O_END;

constexpr int GT_TILE = 128 * 144;
constexpr int LDS_BYTES = 4 * GT_TILE;

struct Params {
  const float* x; const int* pos;
  const float* a_norm_g; const float* a_w_in; const float* a_q_norm_g; const float* a_w_uq; const float* a_kv_norm_g; const float* a_w_ukv;
  const float* a_pool_w; const float* a_pool_scale; const float* a_w_out;
  const float* r_norm_g; const float* r_w_in; const float* r_decay_fwd; const float* r_decay_bwd; const float* r_gn_g; const float* r_w_out;
  const float* final_norm_g;
  float* out; char* ws;
};

#define GAS __attribute__((address_space(1)))
DI u32x4 gld16(const void* p) { return *(const GAS u32x4*)p; }
DI void gst16(void* p, u32x4 v) { *(GAS u32x4*)p = v; }
DI float4 gldf4(const void* p) { typedef float f32x4_t __attribute__((ext_vector_type(4))); f32x4_t v = *(const GAS f32x4_t*)p; return make_float4(v[0], v[1], v[2], v[3]); }
DI void gstf4(void* p, float4 o) { typedef float f32x4_t __attribute__((ext_vector_type(4))); f32x4_t v = {o.x, o.y, o.z, o.w}; *(GAS f32x4_t*)p = v; }
DI uint4 gldu4(const void* p) { u32x4 v = gld16(p); return make_uint4(v[0], v[1], v[2], v[3]); }
DI void gstu4(void* p, uint4 o) { u32x4 v = {o.x, o.y, o.z, o.w}; gst16(p, v); }
DI void gst2(u16* p, u16 v) { *(GAS u16*)p = v; }
typedef __bf16 bf16x2_t __attribute__((ext_vector_type(2)));
typedef float f32x2_t __attribute__((ext_vector_type(2)));
DI unsigned cvtpk(float lo, float hi) { f32x2_t f = {lo, hi}; bf16x2_t b = __builtin_convertvector(f, bf16x2_t); return __builtin_bit_cast(unsigned, b); }
DI u16 f2bf(float x) { return (u16)(cvtpk(x, 0.f) & 0xffffu); }
DI float bflo(unsigned w) { return __uint_as_float(w << 16); }
DI float bfhi(unsigned w) { return __uint_as_float(w & 0xffff0000u); }
DI float bf2f(u16 v) { return __uint_as_float(((unsigned)v) << 16); }
DI float wave_sum(float v) { for (int o = 32; o > 0; o >>= 1) v += __shfl_xor(v, o, 64); return v; }
DI float silu(float g) { return g / (1.f + __expf(-g)); }
DI void store4bf(u16* p, float a, float b, float c, float d) { u32x2 w = {cvtpk(a, b), cvtpk(c, d)}; *(GAS u32x2*)p = w; }
DI void load4bf(const u16* p, float& a, float& b, float& c, float& d) { u32x2 w = *(const GAS u32x2*)p; a = bflo(w[0]); b = bfhi(w[0]); c = bflo(w[1]); d = bfhi(w[1]); }
DI void rope_cs(const unsigned* tab, long mg, int idx, float& c, float& s) {
  unsigned u = *(const GAS unsigned*)(tab + mg * 128 + idx); __half2 h = *reinterpret_cast<__half2*>(&u); c = __low2float(h); s = __high2float(h);
}
DI float log_sigmoid(float x) { return -log1pf(expf(-x)); }

template <class Epi>
DI void gemm_tile(const u16* __restrict__ A, long lda, const u16* __restrict__ Bt, long ldb, int K, char* lds, Epi epi) {
  const int tid = tid_l(), lane = tid & 63, wave = tid >> 6, wm = wave >> 1, wn = wave & 1, l31 = lane & 31, hi = lane >> 5;
  const int lr = tid >> 3, lc = tid & 7;
  const u16* ag = A + (long)lr * lda + lc * 8;
  const u16* bg = Bt + (long)lr * ldb + lc * 8;
  u32x4 ra[4], rb[4];
#pragma unroll
  for (int i = 0; i < 4; ++i) { ra[i] = gld16(ag + (long)(32 * i) * lda); rb[i] = gld16(bg + (long)(32 * i) * ldb); }
  f32x16 acc[2][2];
#pragma unroll
  for (int a = 0; a < 2; ++a)
#pragma unroll
    for (int b = 0; b < 2; ++b)
#pragma unroll
      for (int r = 0; r < 16; ++r) acc[a][b][r] = 0.f;
  char* wbase = lds + lr * 144 + lc * 16;
#pragma unroll
  for (int i = 0; i < 4; ++i) { *reinterpret_cast<u32x4*>(wbase + i * 32 * 144) = ra[i]; *reinterpret_cast<u32x4*>(wbase + GT_TILE + i * 32 * 144) = rb[i]; }
  __syncthreads();
  const int nk = K >> 6;
  for (int kt = 0; kt < nk; ++kt) {
    const int cur = kt & 1;
    if (kt + 1 < nk) {
#pragma unroll
      for (int i = 0; i < 4; ++i) {
        ra[i] = gld16(ag + (long)(32 * i) * lda + (kt + 1) * 64);
        rb[i] = gld16(bg + (long)(32 * i) * ldb + (kt + 1) * 64);
      }
    }
    __builtin_amdgcn_sched_barrier(0);
    const char* as = lds + cur * 2 * GT_TILE + (wm * 64 + l31) * 144 + hi * 16;
    const char* bs = lds + cur * 2 * GT_TILE + GT_TILE + (wn * 64 + l31) * 144 + hi * 16;
#pragma unroll
    for (int kk = 0; kk < 4; ++kk) {
      bf16x8 a0 = *reinterpret_cast<const bf16x8*>(as + kk * 32);
      bf16x8 a1 = *reinterpret_cast<const bf16x8*>(as + 32 * 144 + kk * 32);
      bf16x8 b0 = *reinterpret_cast<const bf16x8*>(bs + kk * 32);
      bf16x8 b1 = *reinterpret_cast<const bf16x8*>(bs + 32 * 144 + kk * 32);
      acc[0][0] = MFMA32(b0, a0, acc[0][0]);
      acc[0][1] = MFMA32(b0, a1, acc[0][1]);
      acc[1][0] = MFMA32(b1, a0, acc[1][0]);
      acc[1][1] = MFMA32(b1, a1, acc[1][1]);
    }
    if (kt + 1 < nk) {
      char* wb = wbase + (cur ^ 1) * 2 * GT_TILE;
#pragma unroll
      for (int i = 0; i < 4; ++i) { *reinterpret_cast<u32x4*>(wb + i * 32 * 144) = ra[i]; *reinterpret_cast<u32x4*>(wb + GT_TILE + i * 32 * 144) = rb[i]; }
    }
    __syncthreads();
  }
#pragma unroll
  for (int ns = 0; ns < 2; ++ns)
#pragma unroll
    for (int ms = 0; ms < 2; ++ms)
#pragma unroll
      for (int g = 0; g < 4; ++g) {
        const int m = wm * 64 + ms * 32 + l31, n = wn * 64 + ns * 32 + 8 * g + 4 * hi;
        epi(m, n, acc[ns][ms][4 * g], acc[ns][ms][4 * g + 1], acc[ns][ms][4 * g + 2], acc[ns][ms][4 * g + 3]);
        __builtin_amdgcn_sched_barrier(0);
      }
}

DI int map_row(int mode, int n) {
  if (mode == 1) { if (n >= 512 && n < 576) { int j = n - 512; return 512 + (j < 32 ? 2 * j : 2 * (j - 32) + 1); } return n; }
  if (mode == 2) { int w = n % 192; if (w >= 128) { int j = w - 128; return n - w + 128 + (j < 32 ? 2 * j : 2 * (j - 32) + 1); } return n; }
  if (mode == 3) { if (n < 2048) { int w = n & 255; return n - w + (w < 128 ? 2 * w : 2 * (w - 128) + 1); } return n; }
  return n;
}
DI void transpose_job(const float* __restrict__ src, int K, int N, u16* __restrict__ dst, int mode, float* lds) {
  const int ntn = N >> 6, ntiles = (K >> 6) * ntn, tid = tid_l(), c = tid & 63, r0 = tid >> 6;
  for (int tile = blockIdx.x; tile < ntiles; tile += gridDim.x) {
    const int kt = tile / ntn, nt = tile - kt * ntn;
#pragma unroll 4
    for (int i = 0; i < 16; ++i) { int r = r0 + 4 * i; lds[r * 65 + c] = src[(long)(kt * 64 + r) * N + nt * 64 + c]; }
    __syncthreads();
#pragma unroll 4
    for (int i = 0; i < 16; ++i) { int rr = r0 + 4 * i; int dn = map_row(mode, nt * 64 + rr); dst[(long)dn * K + kt * 64 + c] = f2bf(lds[c * 65 + rr]); }
    __syncthreads();
  }
}

DI void phase_prep(const Params& p, char* lds) {
  float* fl = reinterpret_cast<float*>(lds);
  char* ws = p.ws;
  for (int i = 0; i < 2; ++i) {
    transpose_job(p.a_w_in + (size_t)i * 1024 * EIN, 1024, EIN, (u16*)(ws + OFF_A_WIN + i * SZ_A_WIN), 1, fl);
    transpose_job(p.a_w_uq + (size_t)i * 384 * 1536, 384, 1536, (u16*)(ws + OFF_A_WUQ + i * SZ_A_WUQ), 2, fl);
    transpose_job(p.a_w_ukv + (size_t)i * 128 * 2048, 128, 2048, (u16*)(ws + OFF_A_WUKV + i * SZ_A_WUKV), 0, fl);
    for (int g = 0; g < 4; ++g)
      transpose_job(p.a_pool_w + ((size_t)i * 4 + g) * 65536, 256, 256, (u16*)(ws + OFF_A_POOL + i * SZ_A_POOL) + g * 65536, 0, fl);
    transpose_job(p.a_w_out + (size_t)i * 2048 * 1024, 2048, 1024, (u16*)(ws + OFF_A_WOUT + i * SZ_A_WOUT), 0, fl);
    transpose_job(p.r_w_in + (size_t)i * 1024 * 6144, 1024, 6144, (u16*)(ws + OFF_R_WIN + i * SZ_R_WIN), 3, fl);
    transpose_job(p.r_w_out + (size_t)i * 2048 * 1024, 2048, 1024, (u16*)(ws + OFF_R_WOUT + i * SZ_R_WOUT), 0, fl);
    u16* pad = (u16*)(ws + OFF_A_WIN + i * SZ_A_WIN) + (size_t)EIN * 1024;
    for (int e = blockIdx.x * NTHR + tid_l(); e < (EIN_PAD - EIN) * 1024; e += gridDim.x * NTHR) pad[e] = 0;
  }
  unsigned* tab = (unsigned*)(ws + OFF_TAB);
  for (int e = blockIdx.x * NTHR + tid_l(); e < M_TOT * 128; e += gridDim.x * NTHR) {
    const int mg = e >> 7, i = e & 127;
    const float inv = exp2f(-(float)i * (13.287712379549449f / 128.f));
    const double ang = (double)p.pos[mg] * (double)inv;
    const double kk = rint(ang * 0.15915494309189535);
    const float r = (float)(ang - kk * 6.283185307179586);
    __half2 h = __floats2half2_rn(__cosf(r), __sinf(r));
    tab[e] = *reinterpret_cast<unsigned*>(&h);
  }
}

DI void phase_rownorm(const float* __restrict__ xin, const float* __restrict__ g, u16* __restrict__ h, int hf) {
  const int lane = tid_l() & 63, gw = blockIdx.x * 4 + (tid_l() >> 6), nw = gridDim.x * 4;
  for (int m = gw; m < MH; m += nw) {
    const float* xr = xin + ((size_t)hf * MH + m) * DM;
    float4 v[4]; float ss = 0.f;
#pragma unroll
    for (int i = 0; i < 4; ++i) { v[i] = gldf4(xr + (i * 64 + lane) * 4); ss += v[i].x * v[i].x + v[i].y * v[i].y + v[i].z * v[i].z + v[i].w * v[i].w; }
    ss = wave_sum(ss);
    const float rs = rsqrtf(ss * (1.f / DM) + EPS);
#pragma unroll
    for (int i = 0; i < 4; ++i) {
      const int c = (i * 64 + lane) * 4; const float4 gg = gldf4(g + c);
      store4bf(h + (size_t)m * DM + c, v[i].x * rs * gg.x, v[i].y * rs * gg.y, v[i].z * rs * gg.z, v[i].w * rs * gg.w);
    }
  }
}

DI void phase_final(float* __restrict__ out, const float* __restrict__ g) {
  const int lane = tid_l() & 63, gw = blockIdx.x * 4 + (tid_l() >> 6), nw = gridDim.x * 4;
  for (int m = gw; m < M_TOT; m += nw) {
    float* xr = out + (size_t)m * DM;
    float4 v[4]; float ss = 0.f;
#pragma unroll
    for (int i = 0; i < 4; ++i) { v[i] = gldf4(xr + (i * 64 + lane) * 4); ss += v[i].x * v[i].x + v[i].y * v[i].y + v[i].z * v[i].z + v[i].w * v[i].w; }
    ss = wave_sum(ss);
    const float rs = rsqrtf(ss * (1.f / DM) + EPS);
#pragma unroll
    for (int i = 0; i < 4; ++i) {
      const int c = (i * 64 + lane) * 4; const float4 gg = gldf4(g + c);
      float4 o; o.x = v[i].x * rs * gg.x; o.y = v[i].y * rs * gg.y; o.z = v[i].z * rs * gg.z; o.w = v[i].w * rs * gg.w;
      gstf4(xr + c, o);
    }
  }
}

DI void phase_even_mid(const Params& p, int li, int hf) {
  char* ws = p.ws;
  const u16* proj = (const u16*)(ws + E_PROJ);
  u16* cqn = (u16*)(ws + E_CQN); u16* ckvn = (u16*)(ws + E_CKVN); u16* kr = (u16*)(ws + E_KR); u16* dp = (u16*)(ws + E_DP);
  const unsigned* tab = (const unsigned*)(ws + OFF_TAB);
  const float* qg = p.a_q_norm_g + li * 384; const float* kvg = p.a_kv_norm_g + li * 128;
  const int lane = tid_l() & 63, gw = blockIdx.x * 4 + (tid_l() >> 6), nw = gridDim.x * 4;
  for (int m = gw; m < MH; m += nw) {
    const u16* pr = proj + (size_t)m * EIN;
    const long mg = (long)hf * MH + m;
    uint4 w = gldu4(pr + lane * 8);
    float f[8] = {bflo(w.x), bfhi(w.x), bflo(w.y), bfhi(w.y), bflo(w.z), bfhi(w.z), bflo(w.w), bfhi(w.w)};
    float ss = 0.f;
#pragma unroll
    for (int j = 0; j < 8; ++j) ss += f[j] * f[j];
    float ssq = wave_sum(lane < 48 ? ss : 0.f), sskv = wave_sum(lane >= 48 ? ss : 0.f);
    const float rq = rsqrtf(ssq * (1.f / 384.f) + EPS), rkv = rsqrtf(sskv * (1.f / 128.f) + EPS);
    if (lane < 48) {
      const float* gp = qg + lane * 8; uint4 o;
      o.x = cvtpk(f[0] * rq * gp[0], f[1] * rq * gp[1]); o.y = cvtpk(f[2] * rq * gp[2], f[3] * rq * gp[3]);
      o.z = cvtpk(f[4] * rq * gp[4], f[5] * rq * gp[5]); o.w = cvtpk(f[6] * rq * gp[6], f[7] * rq * gp[7]);
      gstu4(cqn + (size_t)m * 384 + lane * 8, o);
    } else {
      const int c = (lane - 48) * 8; const float* gp = kvg + c; uint4 o;
      o.x = cvtpk(f[0] * rkv * gp[0], f[1] * rkv * gp[1]); o.y = cvtpk(f[2] * rkv * gp[2], f[3] * rkv * gp[3]);
      o.z = cvtpk(f[4] * rkv * gp[4], f[5] * rkv * gp[5]); o.w = cvtpk(f[6] * rkv * gp[6], f[7] * rkv * gp[7]);
      gstu4(ckvn + (size_t)m * 128 + c, o);
    }
    if (lane < 32) {
      unsigned kw = *reinterpret_cast<const unsigned*>(pr + 512 + lane * 2);
      float x1 = bflo(kw), x2 = bfhi(kw), c, s; rope_cs(tab, mg, 4 * lane, c, s);
      *reinterpret_cast<unsigned*>(kr + (size_t)m * 64 + lane * 2) = cvtpk(x1 * c - x2 * s, x2 * c + x1 * s);
    }
    const int t = m & (TSEQ - 1);
#pragma unroll
    for (int h2 = 0; h2 < 2; ++h2) {
      const int cb = lane * 8 + h2 * 512, g = (lane >> 5) + 2 * h2, wnd = 2 << g, left = wnd >> 1, right = wnd - 1 - left;
      const int lo = max(t - left, 0), hi = min(t + right, TSEQ - 1);
      float a[8] = {0.f, 0.f, 0.f, 0.f, 0.f, 0.f, 0.f, 0.f};
      for (int tt = lo; tt <= hi; ++tt) {
        uint4 u = gldu4(proj + (size_t)(m + tt - t) * EIN + U0 + cb);
        a[0] += bflo(u.x); a[1] += bfhi(u.x); a[2] += bflo(u.y); a[3] += bfhi(u.y); a[4] += bflo(u.z); a[5] += bfhi(u.z); a[6] += bflo(u.w); a[7] += bfhi(u.w);
      }
      const float ic = 1.f / (float)(hi - lo + 1);
      uint4 u = gldu4(pr + U0 + cb); uint4 o;
      o.x = cvtpk(a[0] * ic - bflo(u.x), a[1] * ic - bfhi(u.x)); o.y = cvtpk(a[2] * ic - bflo(u.y), a[3] * ic - bfhi(u.y));
      o.z = cvtpk(a[4] * ic - bflo(u.z), a[5] * ic - bfhi(u.z)); o.w = cvtpk(a[6] * ic - bflo(u.w), a[7] * ic - bfhi(u.w));
      gstu4(dp + (size_t)m * 1024 + cb, o);
    }
  }
}

constexpr int AK_STRIDE = 400, AV_STRIDE = 136, AK_BYTES = 64 * AK_STRIDE;
DI void attn_item(const u16* __restrict__ q, const u16* __restrict__ kn, const u16* __restrict__ kr, const u16* __restrict__ vT,
                  const u16* __restrict__ proj, u16* __restrict__ y, int item, char* lds) {
  const int qb = item & 15, head = (item >> 4) & 7, bl = item >> 7;
  const int tid = tid_l(), lane = tid & 63, wave = tid >> 6, l31 = lane & 31, hi = lane >> 5;
  const int qrow = bl * TSEQ + qb * 128 + wave * 32 + l31;
  char* Ks = lds; char* Vs = lds + AK_BYTES;
  bf16x8 qf[12];
#pragma unroll
  for (int dd = 0; dd < 12; ++dd) qf[dd] = __builtin_bit_cast(bf16x8, gld16(q + (size_t)qrow * 1536 + head * 192 + dd * 16 + hi * 8));
  f32x16 o[4];
#pragma unroll
  for (int d = 0; d < 4; ++d)
#pragma unroll
    for (int r = 0; r < 16; ++r) o[d][r] = 0.f;
  float mrow = -1e30f, lsum = 0.f;
  constexpr float C = 0.07216878364870322f * 1.4426950408889634f;
  const u16* knsrc = kn + (size_t)(bl * TSEQ + (tid >> 4)) * 1024 + head * 128 + (tid & 15) * 8;
  const u16* krsrc = kr + (size_t)(bl * TSEQ + (tid >> 3)) * 64 + (tid & 7) * 8;
  const int kndst = (tid >> 4) * AK_STRIDE + (tid & 15) * 16, krdst = (tid >> 3) * AK_STRIDE + 256 + (tid & 7) * 16;
  const u16* vsrc = vT + ((size_t)(bl * 8 + head) * 128 + (tid >> 3)) * TSEQ + (tid & 7) * 8;
  const int vdst = (tid >> 3) * AV_STRIDE + (tid & 7) * 16;
  u32x4 kst[6], vst[4];
#pragma unroll
  for (int i = 0; i < 4; ++i) kst[i] = gld16(knsrc + (size_t)(16 * i) * 1024);
#pragma unroll
  for (int i = 0; i < 2; ++i) kst[4 + i] = gld16(krsrc + (size_t)(32 * i) * 64);
#pragma unroll
  for (int i = 0; i < 4; ++i) vst[i] = gld16(vsrc + (size_t)(32 * i) * TSEQ);
#pragma unroll
  for (int i = 0; i < 4; ++i) *reinterpret_cast<u32x4*>(Ks + kndst + 16 * i * AK_STRIDE) = kst[i];
#pragma unroll
  for (int i = 0; i < 2; ++i) *reinterpret_cast<u32x4*>(Ks + krdst + 32 * i * AK_STRIDE) = kst[4 + i];
#pragma unroll
  for (int i = 0; i < 4; ++i) { u32x2* d = reinterpret_cast<u32x2*>(Vs + vdst + 32 * i * AV_STRIDE); d[0] = u32x2{vst[i][0], vst[i][1]}; d[1] = u32x2{vst[i][2], vst[i][3]}; }
  __syncthreads();
  const char* kf = Ks + l31 * AK_STRIDE + hi * 16;
  const char* vf = Vs + l31 * AV_STRIDE + hi * 8;
  for (int j = 0; j < 32; ++j) {
    if (j + 1 < 32) {
#pragma unroll
      for (int i = 0; i < 4; ++i) kst[i] = gld16(knsrc + (size_t)((j + 1) * 64 + 16 * i) * 1024);
#pragma unroll
      for (int i = 0; i < 2; ++i) kst[4 + i] = gld16(krsrc + (size_t)((j + 1) * 64 + 32 * i) * 64);
#pragma unroll
      for (int i = 0; i < 4; ++i) vst[i] = gld16(vsrc + (size_t)(32 * i) * TSEQ + (j + 1) * 64);
    }
    __builtin_amdgcn_sched_barrier(0);
    f32x16 p0, p1;
#pragma unroll
    for (int r = 0; r < 16; ++r) { p0[r] = 0.f; p1[r] = 0.f; }
#pragma unroll
    for (int dd = 0; dd < 12; ++dd) {
      bf16x8 a0 = *reinterpret_cast<const bf16x8*>(kf + dd * 32);
      bf16x8 a1 = *reinterpret_cast<const bf16x8*>(kf + 32 * AK_STRIDE + dd * 32);
      p0 = MFMA32(a0, qf[dd], p0);
      p1 = MFMA32(a1, qf[dd], p1);
    }
    float mx = p0[0];
#pragma unroll
    for (int r = 1; r < 16; ++r) mx = fmaxf(mx, p0[r]);
#pragma unroll
    for (int r = 0; r < 16; ++r) mx = fmaxf(mx, p1[r]);
    mx = fmaxf(mx, __shfl_xor(mx, 32, 64));
    const float mnew = fmaxf(mrow, mx);
    const float alpha = exp2f((mrow - mnew) * C);
    mrow = mnew;
    const float mc = -mnew * C;
    float ps = 0.f;
#pragma unroll
    for (int r = 0; r < 16; ++r) { p0[r] = exp2f(fmaf(p0[r], C, mc)); ps += p0[r]; }
#pragma unroll
    for (int r = 0; r < 16; ++r) { p1[r] = exp2f(fmaf(p1[r], C, mc)); ps += p1[r]; }
    lsum = lsum * alpha + ps;
#pragma unroll
    for (int d = 0; d < 4; ++d)
#pragma unroll
      for (int r = 0; r < 16; ++r) o[d][r] *= alpha;
    bf16x8 pf[4];
#pragma unroll
    for (int s = 0; s < 2; ++s) {
      unsigned w0 = cvtpk(p0[8 * s], p0[8 * s + 1]), w1 = cvtpk(p0[8 * s + 2], p0[8 * s + 3]), w2 = cvtpk(p0[8 * s + 4], p0[8 * s + 5]), w3 = cvtpk(p0[8 * s + 6], p0[8 * s + 7]);
      u32x4 u = {w0, w1, w2, w3}; pf[s] = __builtin_bit_cast(bf16x8, u);
      unsigned x0 = cvtpk(p1[8 * s], p1[8 * s + 1]), x1 = cvtpk(p1[8 * s + 2], p1[8 * s + 3]), x2 = cvtpk(p1[8 * s + 4], p1[8 * s + 5]), x3 = cvtpk(p1[8 * s + 6], p1[8 * s + 7]);
      u32x4 u2 = {x0, x1, x2, x3}; pf[2 + s] = __builtin_bit_cast(bf16x8, u2);
    }
#pragma unroll
    for (int s = 0; s < 4; ++s)
#pragma unroll
      for (int db = 0; db < 4; ++db) {
        const s16x4 lo4 = *reinterpret_cast<const s16x4*>(vf + db * 32 * AV_STRIDE + s * 32);
        const s16x4 hi4 = *reinterpret_cast<const s16x4*>(vf + db * 32 * AV_STRIDE + s * 32 + 16);
        const bf16x8 vfrag = __builtin_shufflevector(lo4, hi4, 0, 1, 2, 3, 4, 5, 6, 7);
        o[db] = MFMA32(vfrag, pf[s], o[db]);
      }
    __syncthreads();
    if (j + 1 < 32) {
#pragma unroll
      for (int i = 0; i < 4; ++i) *reinterpret_cast<u32x4*>(Ks + kndst + 16 * i * AK_STRIDE) = kst[i];
#pragma unroll
      for (int i = 0; i < 2; ++i) *reinterpret_cast<u32x4*>(Ks + krdst + 32 * i * AK_STRIDE) = kst[4 + i];
#pragma unroll
      for (int i = 0; i < 4; ++i) { u32x2* d = reinterpret_cast<u32x2*>(Vs + vdst + 32 * i * AV_STRIDE); d[0] = u32x2{vst[i][0], vst[i][1]}; d[1] = u32x2{vst[i][2], vst[i][3]}; }
    }
    __syncthreads();
  }
  lsum += __shfl_xor(lsum, 32, 64);
  const float inv = 1.f / lsum;
#pragma unroll
  for (int db = 0; db < 4; ++db)
#pragma unroll
    for (int g = 0; g < 4; ++g) {
      const int d = db * 32 + 8 * g + 4 * hi;
      float g0, g1, g2, g3; load4bf(proj + (size_t)qrow * EIN + GATE0 + head * 128 + d, g0, g1, g2, g3);
      store4bf(y + (size_t)qrow * 2048 + head * 128 + d, o[db][4 * g] * inv * silu(g0), o[db][4 * g + 1] * inv * silu(g1), o[db][4 * g + 2] * inv * silu(g2), o[db][4 * g + 3] * inv * silu(g3));
    }
}

template <int PH>
DI void run_phase(const Params& p, int layer, int hf, char* lds) {
  char* ws = p.ws;
  asm volatile("" : "+s"(ws));
  const int nb = gridDim.x, bid = blockIdx.x, li = layer >> 1;
  const float* xin = (layer == 0 && (DBG_MASK & 1)) ? p.x : p.out;
  const unsigned* tab = (const unsigned*)(ws + OFF_TAB);
  (void)nb; (void)bid; (void)li; (void)xin; (void)tab;
  if constexpr (PH == 0) { phase_prep(p, lds); }
  else if constexpr (PH == 14) { phase_final(p.out, p.final_norm_g); }
  else if constexpr (PH == 16) {
    const u16* b0 = (const u16*)(ws + O_Q); const u16* b1 = (const u16*)(ws + O_K); const u16* b2 = (const u16*)(ws + O_KFT); const u16* b3 = (const u16*)(ws + O_KBT);
    const u16* b4 = (const u16*)(ws + O_VT); const u16* b5 = (const u16*)(ws + O_GATE); const u16* b6 = (const u16*)(ws + O_P); const u16* b7 = (const u16*)(ws + O_O);
    const size_t n64 = 32ull << 20, n128 = 64ull << 20, n32 = 16ull << 20;
    for (size_t e = (size_t)bid * NTHR + tid_l(); e < (size_t)M_TOT * DM; e += (size_t)nb * NTHR) {
      float v = 0.f;
      if (layer == 1) v = bf2f(b0[e % n64]) + bf2f(b1[e % n64]) + bf2f(b2[e % n64]) + bf2f(b3[e % n64]) + bf2f(b4[e % n128]) + bf2f(b5[e % n128]);
      if (layer == 2) v = bf2f(b6[e % n32]);
      if (layer >= 3) v = bf2f(b7[e % n128]);
      p.out[e] = v;
    }
  }
  else if constexpr (PH == 15) {
    const float4* src = reinterpret_cast<const float4*>(p.x); float4* dst = reinterpret_cast<float4*>(p.out);
    for (size_t e = (size_t)bid * NTHR + tid_l(); e < (size_t)M_TOT * DM / 4; e += (size_t)nb * NTHR) dst[e] = src[e];
  }
  else if constexpr (PH >= 1 && PH <= 6) {
        u16* h = (u16*)(ws + E_H); u16* proj = (u16*)(ws + E_PROJ); u16* cqn = (u16*)(ws + E_CQN); u16* ckvn = (u16*)(ws + E_CKVN); u16* kr = (u16*)(ws + E_KR);
        u16* dp = (u16*)(ws + E_DP); u16* q = (u16*)(ws + E_Q); u16* kn = (u16*)(ws + E_KN); u16* vT = (u16*)(ws + E_VT); u16* y = (u16*)(ws + E_Y);
        const u16* winT = (const u16*)(ws + OFF_A_WIN + li * SZ_A_WIN); const u16* wuqT = (const u16*)(ws + OFF_A_WUQ + li * SZ_A_WUQ);
        const u16* wukvT = (const u16*)(ws + OFF_A_WUKV + li * SZ_A_WUKV); const u16* poolT = (const u16*)(ws + OFF_A_POOL + li * SZ_A_POOL);
        const u16* woutT = (const u16*)(ws + OFF_A_WOUT + li * SZ_A_WOUT);
        if constexpr (PH == 1) {
        phase_rownorm(xin, p.a_norm_g + li * DM, h, hf);
        }
        if constexpr (PH == 2) {
        for (int tile = bid; tile < 256 * 29; tile += nb) {
          const int mt = tile / 29, nt = tile - mt * 29, m0 = mt * 128, n0 = nt * 128;
          gemm_tile(h + (size_t)m0 * DM, DM, winT + (size_t)n0 * DM, DM, DM, lds, [=](int m, int n, float v0, float v1, float v2, float v3) {
            if (n0 + n < EIN) store4bf(proj + (size_t)(m0 + m) * EIN + n0 + n, v0, v1, v2, v3);
          });
        }
        }
        if constexpr (PH == 3) {
        phase_even_mid(p, li, hf);
        }
        if constexpr (PH == 4) {
        for (int tile = bid; tile < 256 * 36; tile += nb) {
          const int mt = tile / 36, nt = tile - mt * 36, m0 = mt * 128;
          if (nt < 12) {
            const int n0 = nt * 128;
            gemm_tile(cqn + (size_t)m0 * 384, 384, wuqT + (size_t)n0 * 384, 384, 384, lds, [=](int m, int n, float v0, float v1, float v2, float v3) {
              const int nn = n0 + n, w = nn % 192;
              if (w >= 128) {
                const long mg = (long)hf * MH + m0 + m; const int pi = (w - 128) >> 1; float c0, s0, c1, s1;
                rope_cs(tab, mg, 4 * pi, c0, s0); rope_cs(tab, mg, 4 * pi + 4, c1, s1);
                const float a = v0 * c0 - v1 * s0, b = v1 * c0 + v0 * s0, c = v2 * c1 - v3 * s1, d = v3 * c1 + v2 * s1;
                v0 = a; v1 = b; v2 = c; v3 = d;
              }
              store4bf(q + (size_t)(m0 + m) * 1536 + nn, v0, v1, v2, v3);
            });
          } else if (nt < 28) {
            const int n0 = (nt - 12) * 128;
            gemm_tile(ckvn + (size_t)m0 * 128, 128, wukvT + (size_t)n0 * 128, 128, 128, lds, [=](int m, int n, float v0, float v1, float v2, float v3) {
              const int nn = n0 + n, head = nn >> 8, w = nn & 255, mm = m0 + m;
              if (w < 128) store4bf(kn + (size_t)mm * 1024 + head * 128 + w, v0, v1, v2, v3);
              else {
                u16* d = vT + ((size_t)((mm >> 11) * 8 + head) * 128 + (w - 128)) * TSEQ + (mm & (TSEQ - 1));
                gst2(d, f2bf(v0)); gst2(d + TSEQ, f2bf(v1)); gst2(d + 2 * TSEQ, f2bf(v2)); gst2(d + 3 * TSEQ, f2bf(v3));
              }
            });
          } else {
            const int pt = nt - 28, g = pt >> 1, n0 = pt * 128;
            const float* psc = p.a_pool_scale + li * 1024;
            gemm_tile(dp + (size_t)m0 * 1024 + g * 256, 1024, poolT + (size_t)n0 * 256, 256, 256, lds, [=](int m, int n, float v0, float v1, float v2, float v3) {
              const int nn = n0 + n, mm = m0 + m; float g0, g1, g2, g3;
              load4bf(proj + (size_t)mm * EIN + GATE0 + 1024 + nn, g0, g1, g2, g3);
              const float4 sc = gldf4(psc + nn);
              store4bf(y + (size_t)mm * 2048 + 1024 + nn, v0 * sc.x * silu(g0), v1 * sc.y * silu(g1), v2 * sc.z * silu(g2), v3 * sc.w * silu(g3));
            });
          }
        }
        }
        if constexpr (PH == 5) {
                for (int item = bid; item < 2048; item += nb) attn_item(q, kn, kr, vT, proj, y, item, lds);
        }
        if constexpr (PH == 6) {
        for (int tile = bid; tile < 256 * 8; tile += nb) {
          const int mt = tile >> 3, nt = tile & 7, m0 = mt * 128, n0 = nt * 128;
          float* outp = p.out;
          gemm_tile(y + (size_t)m0 * 2048, 2048, woutT + (size_t)n0 * 2048, 2048, 2048, lds, [=](int m, int n, float v0, float v1, float v2, float v3) {
            const size_t idx = ((size_t)hf * MH + m0 + m) * DM + n0 + n;
            const float4 xr = gldf4(xin + idx);
            float4 o; o.x = xr.x + v0; o.y = xr.y + v1; o.z = xr.z + v2; o.w = xr.w + v3;
            gstf4(outp + idx, o);
          });
        }
        }
  } else {
        u16* h = (u16*)(ws + O_H); u16* q = (u16*)(ws + O_Q); u16* k = (u16*)(ws + O_K); u16* kfT = (u16*)(ws + O_KFT); u16* kbT = (u16*)(ws + O_KBT);
        u16* vT = (u16*)(ws + O_VT); u16* gate = (u16*)(ws + O_GATE); u16* ob = (u16*)(ws + O_O); u16* P = (u16*)(ws + O_P);
        float* SF = (float*)(ws + O_SF); u16* SB = (u16*)(ws + O_SB);
        const u16* winT = (const u16*)(ws + OFF_R_WIN + li * SZ_R_WIN); const u16* woutT = (const u16*)(ws + OFF_R_WOUT + li * SZ_R_WOUT);
        float lf[4], lb[4];
#pragma unroll
        for (int i = 0; i < 4; ++i) { lf[i] = log_sigmoid(p.r_decay_fwd[li * 4 + i]); lb[i] = log_sigmoid(p.r_decay_bwd[li * 4 + i]); }
        if constexpr (PH == 7) {
        phase_rownorm(xin, p.r_norm_g + li * DM, h, hf);
        }
        if constexpr (PH == 8) {
        for (int tile = bid; tile < 256 * 48; tile += nb) {
          const int mt = tile / 48, nt = tile - mt * 48, m0 = mt * 128, n0 = nt * 128;
          const int head4 = (nt >> 1) & 3;
          const float lfh = head4 == 0 ? lf[0] : head4 == 1 ? lf[1] : head4 == 2 ? lf[2] : lf[3];
          const float lbh = head4 == 0 ? lb[0] : head4 == 1 ? lb[1] : head4 == 2 ? lb[2] : lb[3];
          gemm_tile(h + (size_t)m0 * DM, DM, winT + (size_t)n0 * DM, DM, DM, lds, [=](int m, int n, float v0, float v1, float v2, float v3) {
            const int nn = n0 + n, mm = m0 + m;
            if (nn < 2048) {
              const long mg = (long)hf * MH + mm; const int pi = (nn & 255) >> 1; float c0, s0, c1, s1;
              rope_cs(tab, mg, pi, c0, s0); rope_cs(tab, mg, pi + 1, c1, s1);
              float a = v0 * c0 - v1 * s0, b = v1 * c0 + v0 * s0, c = v2 * c1 - v3 * s1, d = v3 * c1 + v2 * s1;
              if (nn < 1024) store4bf(q + (size_t)mm * 1024 + nn, a, b, c, d);
              else {
                a *= 0.0625f; b *= 0.0625f; c *= 0.0625f; d *= 0.0625f;
                const int kc = nn - 1024;
                store4bf(k + (size_t)mm * 1024 + kc, a, b, c, d);
                const int t = mm & (TSEQ - 1), j = t & 127;
                const float zf = __expf((float)(127 - j) * lfh), zb = __expf((float)j * lbh);
                const size_t base = ((size_t)((mm >> 11) * 4 + (kc >> 8)) * 256 + (kc & 255)) * TSEQ + t;
                gst2(kfT + base, f2bf(a * zf)); gst2(kfT + base + TSEQ, f2bf(b * zf)); gst2(kfT + base + 2 * TSEQ, f2bf(c * zf)); gst2(kfT + base + 3 * TSEQ, f2bf(d * zf));
                gst2(kbT + base, f2bf(a * zb)); gst2(kbT + base + TSEQ, f2bf(b * zb)); gst2(kbT + base + 2 * TSEQ, f2bf(c * zb)); gst2(kbT + base + 3 * TSEQ, f2bf(d * zb));
              }
            } else if (nn < 4096) {
              const int vc = nn - 2048;
              const size_t base = ((size_t)((mm >> 11) * 4 + (vc >> 9)) * 512 + (vc & 511)) * TSEQ + (mm & (TSEQ - 1));
              gst2(vT + base, f2bf(v0)); gst2(vT + base + TSEQ, f2bf(v1)); gst2(vT + base + 2 * TSEQ, f2bf(v2)); gst2(vT + base + 3 * TSEQ, f2bf(v3));
            } else {
              store4bf(gate + (size_t)mm * 2048 + nn - 4096, v0, v1, v2, v3);
            }
          });
        }
        }
        if constexpr (PH == 9) {
        for (int item = bid; item < 1024; item += nb) {
          const int c = item & 15, hd = (item >> 4) & 3, bl = item >> 6;
          const size_t r0 = (size_t)(bl * TSEQ + c * 128) * 1024 + hd * 256;
          const float lfh = hd == 0 ? lf[0] : hd == 1 ? lf[1] : hd == 2 ? lf[2] : lf[3];
          const float lbh = hd == 0 ? lb[0] : hd == 1 ? lb[1] : hd == 2 ? lb[2] : lb[3];
          u16* Pi = P + (size_t)item * 16384;
          gemm_tile(q + r0, 1024, k + r0, 1024, 256, lds, [=](int m, int n, float v0, float v1, float v2, float v3) {
            float v[4] = {v0, v1, v2, v3};
#pragma unroll
            for (int e = 0; e < 4; ++e) { const int d = m - (n + e); v[e] *= d >= 0 ? __expf((float)d * lfh) : __expf((float)(-d) * lbh); }
            store4bf(Pi + m * 128 + n, v[0], v[1], v[2], v[3]);
          });
        }
        }
        if constexpr (PH == 10) {
        for (int tile = bid; tile < 4096; tile += nb) {
          const int nt = tile & 3, item = tile >> 2, c = item & 15, hd = (item >> 4) & 3, bl = item >> 6;
          const u16* Pi = P + (size_t)item * 16384;
          const u16* vb = vT + ((size_t)(bl * 4 + hd) * 512 + nt * 128) * TSEQ + c * 128;
          u16* od = ob + (size_t)(bl * TSEQ + c * 128) * 2048 + hd * 512 + nt * 128;
          gemm_tile(Pi, 128, vb, TSEQ, 128, lds, [=](int m, int n, float v0, float v1, float v2, float v3) {
            store4bf(od + (size_t)m * 2048 + n, v0, v1, v2, v3);
          });
        }
        }
        if constexpr (PH == 11) {
        for (int item = bid; item < 256; item += nb) {
          const int vs = item & 3, hd = (item >> 2) & 3, bl = item >> 4;
          const float lfh = hd == 0 ? lf[0] : hd == 1 ? lf[1] : hd == 2 ? lf[2] : lf[3];
          const float lbh = hd == 0 ? lb[0] : hd == 1 ? lb[1] : hd == 2 ? lb[2] : lb[3];
          float* Sf = SF + (size_t)item * 32768; u16* Sb = SB + (size_t)item * 32768;
          const u16* va = vT + ((size_t)(bl * 4 + hd) * 512 + vs * 128) * TSEQ;
          for (int dir = 0; dir < 2; ++dir) {
            const float lg = dir ? lfh : lbh;
            const float cdec = __expf(128.f * lg);
            const u16* kT = (dir ? kfT : kbT) + (size_t)(bl * 4 + hd) * 256 * TSEQ;
            for (int step = 0; step < 16; ++step) {
              const int c = dir ? step : 15 - step;
              if (step > 0) {
                u16* od = ob + (size_t)(bl * TSEQ + c * 128) * 2048 + hd * 512 + vs * 128;
                gemm_tile(q + (size_t)(bl * TSEQ + c * 128) * 1024 + hd * 256, 1024, Sb, 256, 256, lds, [=](int m, int n, float v0, float v1, float v2, float v3) {
                  const float xi = dir ? __expf((float)(m + 1) * lg) : __expf((float)(128 - m) * lg);
                  float o0, o1, o2, o3; u16* op = od + (size_t)m * 2048 + n; load4bf(op, o0, o1, o2, o3);
                  store4bf(op, o0 + v0 * xi, o1 + v1 * xi, o2 + v2 * xi, o3 + v3 * xi);
                });
              }
              if (step < 15) {
                for (int dt = 0; dt < 2; ++dt) {
                  gemm_tile(va + c * 128, TSEQ, kT + (size_t)(dt * 128) * TSEQ + c * 128, TSEQ, 128, lds, [=](int m, int n, float v0, float v1, float v2, float v3) {
                    float* sp = Sf + m * 256 + dt * 128 + n;
                    if (step > 0) { const float4 s = gldf4(sp); v0 += cdec * s.x; v1 += cdec * s.y; v2 += cdec * s.z; v3 += cdec * s.w; }
                    float4 o; o.x = v0; o.y = v1; o.z = v2; o.w = v3; gstf4(sp, o);
                    store4bf(Sb + m * 256 + dt * 128 + n, v0, v1, v2, v3);
                  });
                }
              }
              __syncthreads();
            }
          }
        }
        }
        if constexpr (PH == 12) {
        {
          const float* gn = p.r_gn_g + li * 2048;
          const int lane = tid_l() & 63, gw = bid * 4 + (tid_l() >> 6), nw = nb * 4;
          for (int row = gw; row < MH * 4; row += nw) {
            const int m = row >> 2, hd = row & 3; const size_t off = (size_t)m * 2048 + hd * 512 + lane * 8;
            uint4 w = gldu4(ob + off);
            float f[8] = {bflo(w.x), bfhi(w.x), bflo(w.y), bfhi(w.y), bflo(w.z), bfhi(w.z), bflo(w.w), bfhi(w.w)};
            float s = 0.f;
#pragma unroll
            for (int j = 0; j < 8; ++j) s += f[j];
            const float mu = wave_sum(s) * (1.f / 512.f);
            float vv = 0.f;
#pragma unroll
            for (int j = 0; j < 8; ++j) { f[j] -= mu; vv += f[j] * f[j]; }
            const float rs = rsqrtf(wave_sum(vv) * (1.f / 512.f) + EPS);
            uint4 gw4 = gldu4(gate + off);
            float gg[8] = {bflo(gw4.x), bfhi(gw4.x), bflo(gw4.y), bfhi(gw4.y), bflo(gw4.z), bfhi(gw4.z), bflo(gw4.w), bfhi(gw4.w)};
            const float* gp = gn + hd * 512 + lane * 8;
            float r[8];
#pragma unroll
            for (int j = 0; j < 8; ++j) r[j] = f[j] * rs * gp[j] * silu(gg[j]);
            uint4 o; o.x = cvtpk(r[0], r[1]); o.y = cvtpk(r[2], r[3]); o.z = cvtpk(r[4], r[5]); o.w = cvtpk(r[6], r[7]);
            gstu4(ob + off, o);
          }
        }
        }
        if constexpr (PH == 13) {
        for (int tile = bid; tile < 256 * 8; tile += nb) {
          const int mt = tile >> 3, nt = tile & 7, m0 = mt * 128, n0 = nt * 128;
          float* outp = p.out;
          gemm_tile(ob + (size_t)m0 * 2048, 2048, woutT + (size_t)n0 * 2048, 2048, 2048, lds, [=](int m, int n, float v0, float v1, float v2, float v3) {
            const size_t idx = ((size_t)hf * MH + m0 + m) * DM + n0 + n;
            const float4 xr = gldf4(xin + idx);
            float4 o; o.x = xr.x + v0; o.y = xr.y + v1; o.z = xr.z + v2; o.w = xr.w + v3;
            gstf4(outp + idx, o);
          });
        }
        }
  }
}

#ifndef DBG_MASK
#define DBG_MASK 15
#endif
#ifndef N_LAUNCH_PER_PHASE
#define N_LAUNCH_PER_PHASE 0
#endif

#if N_LAUNCH_PER_PHASE
template <int PH>
__global__ void __launch_bounds__(NTHR, 2) k_phase(Params p, int layer, int hf) {
  extern __shared__ __attribute__((aligned(16))) char lds[];
  run_phase<PH>(p, layer, hf, lds);
}
#else
__global__ void __launch_bounds__(NTHR, 2) fwd_megakernel(Params p) {
  extern __shared__ __attribute__((aligned(16))) char lds[];
  cg::grid_group grid = cg::this_grid();
  run_phase<0>(p, 0, 0, lds);
  grid.sync();
  for (int layer = 0; layer < 4; ++layer) {
    for (int hf = 0; hf < 2; ++hf) {
      if ((layer & 1) == 0) {
        run_phase<1>(p, layer, hf, lds); grid.sync();
        run_phase<2>(p, layer, hf, lds); grid.sync();
        run_phase<3>(p, layer, hf, lds); grid.sync();
        run_phase<4>(p, layer, hf, lds); grid.sync();
        run_phase<5>(p, layer, hf, lds); grid.sync();
        run_phase<6>(p, layer, hf, lds); grid.sync();
      } else {
        run_phase<7>(p, layer, hf, lds); grid.sync();
        run_phase<8>(p, layer, hf, lds); grid.sync();
        run_phase<9>(p, layer, hf, lds); grid.sync();
        run_phase<10>(p, layer, hf, lds); grid.sync();
        run_phase<11>(p, layer, hf, lds); grid.sync();
        run_phase<12>(p, layer, hf, lds); grid.sync();
        run_phase<13>(p, layer, hf, lds); grid.sync();
      }
    }
  }
  run_phase<14>(p, 0, 0, lds);
}
#endif

#if N_LAUNCH_PER_PHASE
template <int PH>
static void launch_phase(const Params& p, int layer, int hf, int grid, hipStream_t stream) {
  static bool attr = false;
  if (!attr) { (void)hipFuncSetAttribute((const void*)k_phase<PH>, hipFuncAttributeMaxDynamicSharedMemorySize, LDS_BYTES); attr = true; }
  hipLaunchKernelGGL(k_phase<PH>, dim3(grid), dim3(NTHR), LDS_BYTES, stream, p, layer, hf);
}
#endif

extern "C" void kernel_launch(void* const* d_in, const int* in_sizes, int n_in, void* d_out, int out_size, void* d_ws, size_t ws_size, hipStream_t stream) {
  static int grid_blocks = 0;
  if (grid_blocks == 0) {
    if (n_in != 18 || ws_size < WS_NEED) { fprintf(stderr, "kernel_launch: n_in %d ws %zu need %zu\n", n_in, ws_size, (size_t)WS_NEED); grid_blocks = -1; return; }
    int dev = 0, cus = 0;
    (void)hipGetDevice(&dev);
    (void)hipDeviceGetAttribute(&cus, hipDeviceAttributeMultiprocessorCount, dev);
#if N_LAUNCH_PER_PHASE
    grid_blocks = cus * 2;
#else
    int per_cu = 0;
    if (hipFuncSetAttribute((const void*)fwd_megakernel, hipFuncAttributeMaxDynamicSharedMemorySize, LDS_BYTES) != hipSuccess) { fprintf(stderr, "hipFuncSetAttribute failed\n"); grid_blocks = -1; return; }
    if (hipOccupancyMaxActiveBlocksPerMultiprocessor(&per_cu, (const void*)fwd_megakernel, NTHR, LDS_BYTES) != hipSuccess || per_cu < 1) { fprintf(stderr, "occupancy query failed\n"); grid_blocks = -1; return; }
    if (per_cu > 2) per_cu = 2;
    grid_blocks = cus * per_cu;
#endif
  }
  if (grid_blocks < 0) return;
  Params p{};
  p.x = (const float*)d_in[0]; p.pos = (const int*)d_in[1];
  p.a_norm_g = (const float*)d_in[2]; p.a_w_in = (const float*)d_in[3]; p.a_q_norm_g = (const float*)d_in[4]; p.a_w_uq = (const float*)d_in[5];
  p.a_kv_norm_g = (const float*)d_in[6]; p.a_w_ukv = (const float*)d_in[7]; p.a_pool_w = (const float*)d_in[8]; p.a_pool_scale = (const float*)d_in[9];
  p.a_w_out = (const float*)d_in[10]; p.r_norm_g = (const float*)d_in[11]; p.r_w_in = (const float*)d_in[12]; p.r_decay_fwd = (const float*)d_in[13];
  p.r_decay_bwd = (const float*)d_in[14]; p.r_gn_g = (const float*)d_in[15]; p.r_w_out = (const float*)d_in[16]; p.final_norm_g = (const float*)d_in[17];
  p.out = (float*)d_out; p.ws = (char*)d_ws;
#if N_LAUNCH_PER_PHASE
  const int g = grid_blocks;
#ifdef DBG_STAGE
  launch_phase<0>(p, 0, 0, g, stream);
  launch_phase<15>(p, 0, 0, g, stream);
  launch_phase<7>(p, 1, 0, g, stream); launch_phase<8>(p, 1, 0, g, stream);
  if (DBG_STAGE >= 2) launch_phase<9>(p, 1, 0, g, stream);
  if (DBG_STAGE >= 3) launch_phase<10>(p, 1, 0, g, stream);
  if (DBG_STAGE >= 4) launch_phase<12>(p, 1, 0, g, stream);
  launch_phase<16>(p, DBG_STAGE, 0, g, stream);
#else
  launch_phase<0>(p, 0, 0, g, stream);
  if (!(DBG_MASK & 1)) launch_phase<15>(p, 0, 0, g, stream);
  for (int layer = 0; layer < 4; ++layer)
    for (int hf = 0; hf < 2; ++hf) {
      if (!((DBG_MASK >> layer) & 1)) continue;
      if ((layer & 1) == 0) {
        launch_phase<1>(p, layer, hf, g, stream); launch_phase<2>(p, layer, hf, g, stream); launch_phase<3>(p, layer, hf, g, stream);
        launch_phase<4>(p, layer, hf, g, stream); launch_phase<5>(p, layer, hf, g, stream); launch_phase<6>(p, layer, hf, g, stream);
      } else {
        launch_phase<7>(p, layer, hf, g, stream); launch_phase<8>(p, layer, hf, g, stream); launch_phase<9>(p, layer, hf, g, stream);
        launch_phase<10>(p, layer, hf, g, stream);
#ifndef DBG_SKIP_SCAN
        launch_phase<11>(p, layer, hf, g, stream);
#endif
        launch_phase<12>(p, layer, hf, g, stream);
        launch_phase<13>(p, layer, hf, g, stream);
      }
    }
  launch_phase<14>(p, 0, 0, g, stream);
#endif
#else
  void* args[] = {&p};
  hipError_t e = hipLaunchCooperativeKernel((const void*)fwd_megakernel, dim3(grid_blocks), dim3(NTHR), args, LDS_BYTES, stream);
  if (e != hipSuccess) fprintf(stderr, "cooperative launch failed: %s (grid %d)\n", hipGetErrorString(e), grid_blocks);
#endif
}
```
